# Optimizing an MI355X kernel written in HIP

```python
import math
import jax
import jax.numpy as jnp
from jax import lax
import numpy as np

D_MODEL = 1024
BATCH = 32
SEQ = 2048
DEPTH = 4

F32 = jnp.float32
MIX_WIDTH = D_MODEL
HALF_MIX = MIX_WIDTH // 2
DA_HEADS = 4
DA_HEAD = HALF_MIX // (2 * DA_HEADS)
DA_ROPE = DA_HEAD // 4
ROPE_THETA = 500000.0
Q_BLOCK = 128
LRU_WIDTH = HALF_MIX
LRU_BLOCKS = 8
LRU_BLOCK = LRU_WIDTH // LRU_BLOCKS
CONV_W = 4
LRU_C = 8.0
S5_WIDTH = HALF_MIX
S5_GROUP = 16
S5_GROUPS = S5_WIDTH // S5_GROUP
S5_STATE = 64
RET_HEADS = 4
RET_QK = HALF_MIX // (2 * RET_HEADS)
RET_V = HALF_MIX // RET_HEADS
RET_THETA = 10000.0
RET_CHUNK = 128
MEM_LEN = 256
XA_HEADS = 4
XA_HEAD = D_MODEL // XA_HEADS
D_FF = ((8 * D_MODEL // 3 + 127) // 128) * 128
DN_ALPHA = (2 * DEPTH) ** 0.25
DN_BETA = (8 * DEPTH) ** -0.25
LN_EPS = 1e-5
N_EVEN = (DEPTH + 1) // 2
N_ODD = DEPTH // 2
EVEN_IN = 3 * HALF_MIX + 2 * LRU_WIDTH
ODD_IN = S5_WIDTH + 2 * RET_HEADS * RET_QK + 2 * RET_HEADS * RET_V

kernel_name = 'hybrid_diffattn_rglru_s5_retention_trunk'


def layer_norm(x, g, b):
    xf = x.astype(F32)
    mu = jnp.mean(xf, -1, keepdims=True)
    var = jnp.mean(jnp.square(xf - mu), -1, keepdims=True)
    return ((xf - mu) * lax.rsqrt(var + LN_EPS) * g.astype(F32) + b.astype(F32)).astype(x.dtype)


def rms_norm(x, g):
    xf = x.astype(F32)
    return xf * lax.rsqrt(jnp.mean(jnp.square(xf), -1, keepdims=True) + LN_EPS) * g.astype(F32)


def head_group_norm(x, g):
    xf = x.astype(F32)
    mu = jnp.mean(xf, -1, keepdims=True)
    var = jnp.mean(jnp.square(xf - mu), -1, keepdims=True)
    return (xf - mu) * lax.rsqrt(var + LN_EPS) * g.astype(F32)


def rotary(x, pos, rot_dim, theta):
    half = rot_dim // 2
    inv = theta ** (-jnp.arange(half, dtype=F32) * 2.0 / rot_dim)
    ang = pos.astype(F32)[:, None] * inv[None, :]
    shape = (1, x.shape[1]) + (1,) * (x.ndim - 3) + (half,)
    cos = jnp.cos(ang).reshape(shape)
    sin = jnp.sin(ang).reshape(shape)
    xf = x.astype(F32)
    x1, x2, xp = xf[..., :half], xf[..., half:rot_dim], xf[..., rot_dim:]
    return jnp.concatenate([x1 * cos - x2 * sin, x1 * sin + x2 * cos, xp], -1).astype(x.dtype)


def swiglu(x, w_gate, w_up, w_down):
    return (jax.nn.silu(x @ w_gate) * (x @ w_up)) @ w_down


def diff_lambda_init(layer):
    return 0.8 - 0.6 * math.exp(-0.3 * layer)


def diff_attention(q, k, v, lam, norm_g, lambda_init):
    B, S, H, _, d = q.shape
    scale = d ** -0.5
    lf = lam.astype(F32)
    lmbda = jnp.exp(jnp.sum(lf[0] * lf[1])) - jnp.exp(jnp.sum(lf[2] * lf[3])) + lambda_init
    nb = S // Q_BLOCK
    qb = q.reshape(B, nb, Q_BLOCK, H, 2, d).transpose(1, 0, 2, 3, 4, 5)
    kpos = jnp.arange(S)

    def block(args):
        qi, i = args
        s = jnp.einsum('bqhmd,bkhmd->bhmqk', qi, k).astype(F32) * scale
        qpos = i * Q_BLOCK + jnp.arange(Q_BLOCK)
        causal = kpos[None, :] <= qpos[:, None]
        p = jax.nn.softmax(jnp.where(causal, s, -jnp.inf), axis=-1)
        w = p[:, :, 0] - lmbda * p[:, :, 1]
        return jnp.einsum('bhqk,bkhe->bqhe', w.astype(v.dtype), v)

    o = lax.map(block, (qb, jnp.arange(nb)))
    o = o.transpose(1, 0, 2, 3, 4).reshape(B, S, H, 2 * d)
    o = rms_norm(o, norm_g) * (1.0 - lambda_init)
    return o.reshape(B, S, H * 2 * d).astype(q.dtype)


def causal_depthwise_conv(x, w, b):
    K, C = w.shape
    y = lax.conv_general_dilated(x, w[:, None, :].astype(x.dtype), window_strides=(1,),
                                 padding=[(K - 1, 0)], dimension_numbers=('NWC', 'WIO', 'NWC'),
                                 feature_group_count=C)
    return y + b.astype(x.dtype)


def linear_combine(left, right):
    a_l, b_l = left
    a_r, b_r = right
    return a_l * a_r, a_r * b_l + b_r


def rg_lru(x, gate_w, gate_b, lam):
    B, S, W = x.shape
    xb = x.reshape(B, S, LRU_BLOCKS, LRU_BLOCK)
    gates = jnp.einsum('bsnc,gncd->gbsnd', xb, gate_w).reshape(2, B, S, W).astype(F32)
    gates = gates + gate_b.astype(F32)[:, None, None, :]
    r = jax.nn.sigmoid(gates[0])
    i = jax.nn.sigmoid(gates[1])
    log_a = -LRU_C * r * jax.nn.softplus(-lam.astype(F32))
    a = jnp.exp(log_a)
    b = jnp.sqrt(-jnp.expm1(2.0 * log_a)) * (i * x.astype(F32))
    _, h = lax.associative_scan(linear_combine, (a, b), axis=1)
    return h.astype(x.dtype)


def complex_combine(left, right):
    ar_l, ai_l, br_l, bi_l = left
    ar_r, ai_r, br_r, bi_r = right
    return (ar_r * ar_l - ai_r * ai_l, ar_r * ai_l + ai_r * ar_l,
            ar_r * br_l - ai_r * bi_l + br_r, ar_r * bi_l + ai_r * br_l + bi_r)


def s5_ssm(u, lam_re, lam_im, log_step, b_re, b_im, c_re, c_im, d_skip, glu_w, glu_b):
    B, S, W = u.shape
    uf = u.astype(F32)
    ug = uf.reshape(B, S, S5_GROUPS, S5_GROUP)
    step = jnp.exp(log_step.astype(F32))[:, None]
    lr = jnp.minimum(lam_re.astype(F32), -1e-4)
    li = lam_im.astype(F32)
    mag = jnp.exp(lr * step)
    ang = li * step
    ab_re, ab_im = mag * jnp.cos(ang), mag * jnp.sin(ang)
    den = lr * lr + li * li
    nr, ni = ab_re - 1.0, ab_im
    f_re = (nr * lr + ni * li) / den
    f_im = (ni * lr - nr * li) / den
    bu_re = jnp.einsum('bsgc,gnc->bsgn', ug, b_re.astype(F32))
    bu_im = jnp.einsum('bsgc,gnc->bsgn', ug, b_im.astype(F32))
    x_re = f_re * bu_re - f_im * bu_im
    x_im = f_re * bu_im + f_im * bu_re
    a_re = jnp.broadcast_to(ab_re[None, None], (1, S, S5_GROUPS, S5_STATE))
    a_im = jnp.broadcast_to(ab_im[None, None], (1, S, S5_GROUPS, S5_STATE))
    _, _, h_re, h_im = lax.associative_scan(complex_combine, (a_re, a_im, x_re, x_im), axis=1)
    y = (jnp.einsum('bsgn,gcn->bsgc', h_re, c_re.astype(F32))
         - jnp.einsum('bsgn,gcn->bsgc', h_im, c_im.astype(F32)))
    y = y.reshape(B, S, W) + d_skip.astype(F32) * uf
    z = jax.nn.gelu(y)
    out = z * jax.nn.sigmoid(z @ glu_w.astype(F32) + glu_b.astype(F32))
    return out.astype(u.dtype)


def retention(q, k, v, g, norm_g, pos):
    B, S, H, dk = q.shape
    dv = v.shape[-1]
    q = rotary(q, pos, dk, RET_THETA).astype(F32)
    k = rotary(k, pos, dk, RET_THETA).astype(F32) * dk ** -0.5
    v = v.astype(F32)
    log_g = jnp.log(1.0 - jnp.exp2(-5.0 - jnp.arange(H, dtype=F32)))
    C = RET_CHUNK
    nc = S // C
    idx = jnp.arange(C, dtype=F32)
    diff = idx[:, None] - idx[None, :]
    causal = diff >= 0
    decay_in = jnp.where(causal[None], jnp.exp(log_g[:, None, None] * jnp.where(causal, diff, 0.0)[None]), 0.0)
    xi = jnp.exp(log_g[:, None] * (idx + 1.0))[None, :, :, None]
    zeta = jnp.exp(log_g[:, None] * (C - 1.0 - idx))[None, :, :, None]
    chunk_decay = jnp.exp(log_g * C)[None, :, None, None]
    qc = q.reshape(B, nc, C, H, dk).transpose(1, 0, 3, 2, 4)
    kc = k.reshape(B, nc, C, H, dk).transpose(1, 0, 3, 2, 4)
    vc = v.reshape(B, nc, C, H, dv).transpose(1, 0, 3, 2, 4)

    def step(R, inp):
        qi, ki, vi = inp
        inner = jnp.einsum('bhqd,bhkd->bhqk', qi, ki) * decay_in[None]
        o = (jnp.einsum('bhqk,bhke->bhqe', inner, vi)
             + jnp.einsum('bhqd,bhde->bhqe', qi, R) * xi)
        R = chunk_decay * R + jnp.einsum('bhkd,bhke->bhde', ki * zeta, vi)
        return R, o

    R0 = jnp.zeros((B, H, dk, dv), F32)
    _, o = lax.scan(step, R0, (qc, kc, vc))
    o = o.transpose(1, 0, 3, 2, 4).reshape(B, S, H, dv)
    o = head_group_norm(o, norm_g).reshape(B, S, H * dv)
    return (jax.nn.silu(g.astype(F32)) * o).astype(g.dtype)


def even_mixer(x, pos, w_in, w_out, lam, norm_g, conv_w, conv_b, gate_w, gate_b, lru_lam, lambda_init):
    B, S, _ = x.shape
    z = x @ w_in
    q, k, v, gate, xr = jnp.split(z, [HALF_MIX, 2 * HALF_MIX, 3 * HALF_MIX, 3 * HALF_MIX + LRU_WIDTH], axis=-1)
    q = rotary(q.reshape(B, S, DA_HEADS, 2, DA_HEAD), pos, DA_ROPE, ROPE_THETA)
    k = rotary(k.reshape(B, S, DA_HEADS, 2, DA_HEAD), pos, DA_ROPE, ROPE_THETA)
    v = v.reshape(B, S, DA_HEADS, 2 * DA_HEAD)
    a_out = diff_attention(q, k, v, lam, norm_g, lambda_init)
    h = rg_lru(causal_depthwise_conv(xr, conv_w, conv_b), gate_w, gate_b, lru_lam)
    b_out = jax.nn.gelu(gate) * h
    return jnp.concatenate([a_out, b_out], axis=-1) @ w_out


def odd_mixer(x, pos, w_in, w_out, lam_re, lam_im, log_step, b_re, b_im, c_re, c_im, d_skip, glu_w, glu_b, ret_g):
    B, S, _ = x.shape
    z = x @ w_in
    o1 = S5_WIDTH
    o2 = o1 + RET_HEADS * RET_QK
    o3 = o2 + RET_HEADS * RET_QK
    o4 = o3 + RET_HEADS * RET_V
    u, q, k, v, g = jnp.split(z, [o1, o2, o3, o4], axis=-1)
    c_out = s5_ssm(u, lam_re, lam_im, log_step, b_re, b_im, c_re, c_im, d_skip, glu_w, glu_b)
    d_out = retention(q.reshape(B, S, RET_HEADS, RET_QK), k.reshape(B, S, RET_HEADS, RET_QK),
                      v.reshape(B, S, RET_HEADS, RET_V), g, ret_g, pos)
    return jnp.concatenate([c_out, d_out], axis=-1) @ w_out


def memory_cross_attention(x, mem, w_q, w_kv, w_o):
    B, S, _ = x.shape
    M = mem.shape[1]
    q = (x @ w_q).reshape(B, S, XA_HEADS, XA_HEAD)
    kv = (mem @ w_kv).reshape(B, M, 2, XA_HEADS, XA_HEAD)
    s = jnp.einsum('bshd,bmhd->bhsm', q, kv[:, :, 0]).astype(F32) * XA_HEAD ** -0.5
    p = jax.nn.softmax(s, axis=-1)
    o = jnp.einsum('bhsm,bmhd->bshd', p.astype(x.dtype), kv[:, :, 1]).reshape(B, S, D_MODEL)
    return o @ w_o


def setup_inputs(seed: int = 0) -> dict:
    key = jax.random.key(seed)
    ks = iter(jax.random.split(key, 40))

    def nrm(shape, scale):
        return jax.random.normal(next(ks), shape, F32) * scale

    x = nrm((BATCH, SEQ, D_MODEL), 1.0)
    mem = nrm((BATCH, MEM_LEN, D_MODEL), 1.0)
    ln_g = 1.0 + nrm((DEPTH, 4, D_MODEL), 0.02)
    ln_b = nrm((DEPTH, 4, D_MODEL), 0.02)
    ffn_w_gate = nrm((DEPTH, 2, D_MODEL, D_FF), D_MODEL ** -0.5)
    ffn_w_up = nrm((DEPTH, 2, D_MODEL, D_FF), D_MODEL ** -0.5)
    ffn_w_down = nrm((DEPTH, 2, D_FF, D_MODEL), D_FF ** -0.5 * DN_BETA)
    xa_w_q = nrm((DEPTH, D_MODEL, D_MODEL), D_MODEL ** -0.5)
    xa_w_kv = nrm((DEPTH, D_MODEL, 2 * D_MODEL), D_MODEL ** -0.5)
    xa_w_o = nrm((DEPTH, D_MODEL, D_MODEL), D_MODEL ** -0.5 * DN_BETA)
    ev_w_in = nrm((N_EVEN, D_MODEL, EVEN_IN), D_MODEL ** -0.5)
    ev_w_out = nrm((N_EVEN, MIX_WIDTH, D_MODEL), MIX_WIDTH ** -0.5 * DN_BETA)
    da_lambda = nrm((N_EVEN, 4, DA_HEAD), 0.1)
    da_norm_g = 1.0 + nrm((N_EVEN, 2 * DA_HEAD), 0.02)
    lru_conv_w = nrm((N_EVEN, CONV_W, LRU_WIDTH), CONV_W ** -0.5)
    lru_conv_b = nrm((N_EVEN, LRU_WIDTH), 0.02)
    lru_gate_w = nrm((N_EVEN, 2, LRU_BLOCKS, LRU_BLOCK, LRU_BLOCK), LRU_BLOCK ** -0.5)
    lru_gate_b = nrm((N_EVEN, 2, LRU_WIDTH), 0.02)
    a_c = jax.random.uniform(next(ks), (N_EVEN, LRU_WIDTH), F32, 0.9, 0.999)
    a0 = a_c ** (1.0 / LRU_C)
    lru_lambda = jnp.log(a0) - jnp.log1p(-a0)
    od_w_in = nrm((N_ODD, D_MODEL, ODD_IN), D_MODEL ** -0.5)
    od_w_out = nrm((N_ODD, MIX_WIDTH, D_MODEL), MIX_WIDTH ** -0.5 * DN_BETA)
    s5_lam_re = -0.5 + nrm((N_ODD, S5_GROUPS, S5_STATE), 0.01)
    s5_lam_im = jnp.pi * jnp.arange(S5_STATE, dtype=F32) + nrm((N_ODD, S5_GROUPS, S5_STATE), 0.01)
    s5_log_step = jax.random.uniform(next(ks), (N_ODD, S5_GROUPS), F32, math.log(1e-3), math.log(1e-1))
    s5_b_re = nrm((N_ODD, S5_GROUPS, S5_STATE, S5_GROUP), (2 * S5_GROUP) ** -0.5)
    s5_b_im = nrm((N_ODD, S5_GROUPS, S5_STATE, S5_GROUP), (2 * S5_GROUP) ** -0.5)
    s5_c_re = nrm((N_ODD, S5_GROUPS, S5_GROUP, S5_STATE), S5_STATE ** -0.5)
    s5_c_im = nrm((N_ODD, S5_GROUPS, S5_GROUP, S5_STATE), S5_STATE ** -0.5)
    s5_d = nrm((N_ODD, S5_WIDTH), 1.0)
    s5_glu_w = nrm((N_ODD, S5_WIDTH, S5_WIDTH), S5_WIDTH ** -0.5)
    s5_glu_b = nrm((N_ODD, S5_WIDTH), 0.02)
    ret_norm_g = 1.0 + nrm((N_ODD, RET_V), 0.02)
    return {'x': x, 'mem': mem, 'ln_g': ln_g, 'ln_b': ln_b,
            'ffn_w_gate': ffn_w_gate, 'ffn_w_up': ffn_w_up, 'ffn_w_down': ffn_w_down,
            'xa_w_q': xa_w_q, 'xa_w_kv': xa_w_kv, 'xa_w_o': xa_w_o,
            'ev_w_in': ev_w_in, 'ev_w_out': ev_w_out, 'da_lambda': da_lambda, 'da_norm_g': da_norm_g,
            'lru_conv_w': lru_conv_w, 'lru_conv_b': lru_conv_b, 'lru_gate_w': lru_gate_w,
            'lru_gate_b': lru_gate_b, 'lru_lambda': lru_lambda,
            'od_w_in': od_w_in, 'od_w_out': od_w_out, 's5_lam_re': s5_lam_re, 's5_lam_im': s5_lam_im,
            's5_log_step': s5_log_step, 's5_b_re': s5_b_re, 's5_b_im': s5_b_im,
            's5_c_re': s5_c_re, 's5_c_im': s5_c_im, 's5_d': s5_d, 's5_glu_w': s5_glu_w,
            's5_glu_b': s5_glu_b, 'ret_norm_g': ret_norm_g}


def reference(x, mem, ln_g, ln_b, ffn_w_gate, ffn_w_up, ffn_w_down, xa_w_q, xa_w_kv, xa_w_o,
              ev_w_in, ev_w_out, da_lambda, da_norm_g, lru_conv_w, lru_conv_b, lru_gate_w,
              lru_gate_b, lru_lambda, od_w_in, od_w_out, s5_lam_re, s5_lam_im, s5_log_step,
              s5_b_re, s5_b_im, s5_c_re, s5_c_im, s5_d, s5_glu_w, s5_glu_b, ret_norm_g):
    S = x.shape[1]
    pos = jnp.arange(S, dtype=jnp.int32)
    for l in range(DEPTH):
        h = swiglu(x, ffn_w_gate[l, 0], ffn_w_up[l, 0], ffn_w_down[l, 0])
        x = layer_norm(DN_ALPHA * x + 0.5 * h, ln_g[l, 0], ln_b[l, 0])
        if l % 2 == 0:
            e = l // 2
            m = even_mixer(x, pos, ev_w_in[e], ev_w_out[e], da_lambda[e], da_norm_g[e],
                           lru_conv_w[e], lru_conv_b[e], lru_gate_w[e], lru_gate_b[e],
                           lru_lambda[e], diff_lambda_init(l))
        else:
            o = l // 2
            m = odd_mixer(x, pos, od_w_in[o], od_w_out[o], s5_lam_re[o], s5_lam_im[o],
                          s5_log_step[o], s5_b_re[o], s5_b_im[o], s5_c_re[o], s5_c_im[o],
                          s5_d[o], s5_glu_w[o], s5_glu_b[o], ret_norm_g[o])
        x = layer_norm(DN_ALPHA * x + m, ln_g[l, 1], ln_b[l, 1])
        c = memory_cross_attention(x, mem, xa_w_q[l], xa_w_kv[l], xa_w_o[l])
        x = layer_norm(DN_ALPHA * x + c, ln_g[l, 2], ln_b[l, 2])
        h = swiglu(x, ffn_w_gate[l, 1], ffn_w_up[l, 1], ffn_w_down[l, 1])
        x = layer_norm(DN_ALPHA * x + 0.5 * h, ln_g[l, 3], ln_b[l, 3])
    return x
```

```cpp
#include <hip/hip_runtime.h>
#include <hip/hip_cooperative_groups.h>
#include <cstdio>
#include <cstdint>
#include <type_traits>
namespace cg = cooperative_groups;
__device__ __forceinline__ float xsum16(float v) { auto rr = __builtin_amdgcn_permlane16_swap(__float_as_uint(v), __float_as_uint(v), false, false); return __uint_as_float(rr[0]) + __uint_as_float(rr[1]); }
__device__ __forceinline__ float xsum32(float v) { auto rr = __builtin_amdgcn_permlane32_swap(__float_as_uint(v), __float_as_uint(v), false, false); return __uint_as_float(rr[0]) + __uint_as_float(rr[1]); }
__device__ __forceinline__ float xmax16(float v) { auto rr = __builtin_amdgcn_permlane16_swap(__float_as_uint(v), __float_as_uint(v), false, false); return fmaxf(__uint_as_float(rr[0]), __uint_as_float(rr[1])); }
__device__ __forceinline__ float xmax32(float v) { auto rr = __builtin_amdgcn_permlane32_swap(__float_as_uint(v), __float_as_uint(v), false, false); return fmaxf(__uint_as_float(rr[0]), __uint_as_float(rr[1])); }
__device__ __forceinline__ float xsum_rows(float v) { return xsum32(xsum16(v)); }
__device__ __forceinline__ float xmax_rows(float v) { return xmax32(xmax16(v)); }
namespace pg8 {
#define PG8_LAS __attribute__((address_space(3)))
typedef unsigned short bf16_t;
typedef short bf16x8 __attribute__((ext_vector_type(8)));
typedef float f32x4 __attribute__((ext_vector_type(4)));
typedef unsigned u32x4 __attribute__((ext_vector_type(4)));
constexpr int BM = 256, BK = 64, HALF = 128, HTB = HALF * BK * 2  , STAGE_BYTES = 8 * HTB, NXCD = 8, WGM = 8;

__host__ __device__ __forceinline__ int lds_byte(int r, int c) { const int st = (r >> 4) * 2 + (c >> 5), rr = r & 15, cc = c & 31, ob = rr * 64 + cc * 2; return st * 1024 + (ob ^ (((ob >> 9) & 1) << 5)); }
__host__ __device__ __forceinline__ void stage_rc(int b, int& R, int& C) { const int st = b / 1024, sb = b % 1024, swz = sb ^ (((sb >> 9) & 1) << 5); R = (st >> 1) * 16 + swz / 64; C = (st & 1) * 32 + (swz % 64) / 2; }
__host__ __device__ __forceinline__ int perm32(int rho) { const int n = rho >> 4, i = rho & 15; return 8 * (i >> 2) + 4 * n + (i & 3); }

struct Unit { int pm, pn; };
struct Gemm { const bf16_t* A; const bf16_t* Bt; int M, N, K; };

struct StaticOrder {
    int nM, nN, nwg, G, c;
    __host__ __device__ void init(int M, int N, int G_, int c_) { nM = M / BM; nN = N / BM; nwg = nM * nN; G = G_; c = c_; }
    __host__ __device__ bool next(int i, Unit& u) const {
        const long L = (long)i * G + c; if (L >= nwg) return false;
        int wgid = (int)L; { const int q = nwg / NXCD, r = nwg % NXCD, xcd = wgid % NXCD, off = wgid / NXCD; wgid = (xcd < r ? xcd * (q + 1) : r * (q + 1) + (xcd - r) * q) + off; }
        const int nig = WGM * nN, gid = wgid / nig, fm = gid * WGM, gsz = (nM - fm) < WGM ? (nM - fm) : WGM;
        u.pm = fm + ((wgid % nig) % gsz); u.pn = (wgid % nig) / gsz; return true;
    }
    __device__ __forceinline__ void a_ready(const Unit&) const {}
    __device__ __forceinline__ void done(const Unit&) const {}
};

__device__ __forceinline__ unsigned cvt_pk_bf16(float lo, float hi) { unsigned r; asm volatile("v_cvt_pk_bf16_f32 %0, %1, %2" : "=v"(r) : "v"(lo), "v"(hi)); return r; }
typedef float f32x2 __attribute__((ext_vector_type(2)));
__device__ __forceinline__ float fast_sigmoid(float x) { return __builtin_amdgcn_rcpf(1.0f + __expf(-x)); }

struct LnFix { const float* st; const float* c1; const float* c2; };
__device__ __forceinline__ void ln_row(const float* st, int row, int fq, float& rs, float& ms) {
    f32x2 v = *(const f32x2*)(st + (unsigned)(8 * row + 2 * fq));
    v.x = xsum_rows(v.x); v.y = xsum_rows(v.y);
    const float mean = v.x * (1.0f / 1024.0f); const float var = v.y * (1.0f / 1024.0f) - mean * mean;
    rs = __builtin_amdgcn_rsqf(var + 1e-5f); ms = rs * mean;
}
struct EpiSwiglu {
    static constexpr bool PERM = true, AFTER_DRAIN = false;
    bf16_t* O; int ldo; LnFix ln;
    __device__ __forceinline__ void operator()(const f32x4 (&acc)[2][2][4][2], const Unit& u, int wr, int wc, int fr, int fq, PG8_LAS unsigned char* ldsb) const {
        const int row0 = u.pm * BM + wr * 64 + fr; const int col0 = u.pn * HALF + wc * 32 + 8 * fq;
        const int brow = u.pn * BM + wc * 32 + 8 * fq;
        const PG8_LAS unsigned* CV = (const PG8_LAS unsigned*)(ldsb + 131072);
        PG8_LAS f32x2* ST = (PG8_LAS f32x2*)(ldsb + 153600);
        volatile PG8_LAS int* TAG = (volatile PG8_LAS int*)(ldsb + 155648);
        float rsv[2][4], msv[2][4];
        if (TAG[wr] != u.pm) {
#pragma unroll
            for (int ai = 0; ai < 2; ++ai)
#pragma unroll
                for (int m = 0; m < 4; ++m) { ln_row(ln.st, row0 + ai * HALF + m * 16, fq, rsv[ai][m], msv[ai][m]);
                    f32x2 pr; pr.x = rsv[ai][m]; pr.y = msv[ai][m]; ST[ai * HALF + wr * 64 + m * 16 + fr] = pr; }
            asm volatile("s_waitcnt lgkmcnt(0)" ::: "memory");
            TAG[wr] = u.pm;
        } else {
#pragma unroll
            for (int ai = 0; ai < 2; ++ai)
#pragma unroll
                for (int m = 0; m < 4; ++m) { const f32x2 pr = ST[ai * HALF + wr * 64 + m * 16 + fr]; rsv[ai][m] = pr.x; msv[ai][m] = pr.y; }
        }
        float c1g[8], c2g[8], c1u[8], c2u[8];
        { const u32x4 g0 = *(const PG8_LAS u32x4*)(CV + brow), g1 = *(const PG8_LAS u32x4*)(CV + brow + 4), u0 = *(const PG8_LAS u32x4*)(CV + brow + HALF), u1 = *(const PG8_LAS u32x4*)(CV + brow + HALF + 4);
#pragma unroll
          for (int i = 0; i < 4; ++i) { c1g[i] = __uint_as_float(g0[i] << 16); c2g[i] = __uint_as_float(g0[i] & 0xffff0000u); c1g[4 + i] = __uint_as_float(g1[i] << 16); c2g[4 + i] = __uint_as_float(g1[i] & 0xffff0000u);
              c1u[i] = __uint_as_float(u0[i] << 16); c2u[i] = __uint_as_float(u0[i] & 0xffff0000u); c1u[4 + i] = __uint_as_float(u1[i] << 16); c2u[4 + i] = __uint_as_float(u1[i] & 0xffff0000u); } }
#pragma unroll
        for (int ai = 0; ai < 2; ++ai)
#pragma unroll
            for (int m = 0; m < 4; ++m) {
                bf16_t* p = O + (size_t)(row0 + ai * HALF + m * 16) * ldo + col0;
                const float rs = rsv[ai][m], ms = msv[ai][m];
                float v[8];
#pragma unroll
                for (int n = 0; n < 2; ++n)
#pragma unroll
                    for (int i = 0; i < 4; ++i) { const int e = n * 4 + i; const float g = acc[ai][0][m][n][i] * rs - ms * c1g[e] + c2g[e], up = acc[ai][1][m][n][i] * rs - ms * c1u[e] + c2u[e]; v[e] = g * fast_sigmoid(g) * up; }
                u32x4 w; w.x = cvt_pk_bf16(v[0], v[1]); w.y = cvt_pk_bf16(v[2], v[3]); w.z = cvt_pk_bf16(v[4], v[5]); w.w = cvt_pk_bf16(v[6], v[7]);
                *(u32x4*)p = w;
            }
    }
};
struct EpiResid {
    static constexpr bool PERM = false, AFTER_DRAIN = false;
    float* X; bf16_t* PB; const float* stp; float* stn; const float* gp; const float* bp; float alpha, s;
    template <int AI, int M0, int NR>
    __device__ __forceinline__ void batch(const f32x4 (&acc)[2][2][4][2], int row0, int col0, int wr, int wc, int fr, int fq, PG8_LAS float* red, const PG8_LAS float* gl) const {
        f32x2 xh[NR][2][2], xl[NR][2][2], stv[NR];
#pragma unroll
        for (int mm = 0; mm < NR; ++mm) { const unsigned rr_ = (unsigned)(row0 + AI * HALF + (M0 + mm) * 16); stv[mm] = *(const f32x2*)(stp + (8u * rr_ + 2u * (unsigned)fq));
#pragma unroll
            for (int bj = 0; bj < 2; ++bj)
#pragma unroll
                for (int n = 0; n < 2; ++n) { const unsigned cc_ = (unsigned)(col0 + bj * HALF + n * 16);
                    xh[mm][bj][n] = *(const f32x2*)(PB + (rr_ * 1024u + cc_)); xl[mm][bj][n] = *(const f32x2*)((const bf16_t*)X + (rr_ * 2048u + 1024u + cc_)); } }
#pragma unroll
        for (int mm = 0; mm < NR; ++mm) { const int m = M0 + mm; const int row = row0 + AI * HALF + m * 16;
            float rs, ms; { f32x2 v = stv[mm]; v.x = xsum_rows(v.x); v.y = xsum_rows(v.y);
              const float mean = v.x * (1.0f / 1024.0f); const float var = v.y * (1.0f / 1024.0f) - mean * mean; rs = __builtin_amdgcn_rsqf(var + 1e-5f); ms = rs * mean; }
            const unsigned ro = (unsigned)row * 1024u + (unsigned)col0;
            float sm = 0.f, sq = 0.f;
#pragma unroll
            for (int bj = 0; bj < 2; ++bj)
#pragma unroll
                for (int n = 0; n < 2; ++n) { const unsigned hw0 = __float_as_uint(xh[mm][bj][n].x), hw1 = __float_as_uint(xh[mm][bj][n].y), lw0 = __float_as_uint(xl[mm][bj][n].x), lw1 = __float_as_uint(xl[mm][bj][n].y);
                    f32x4 x; x[0] = __uint_as_float(hw0 << 16) + __uint_as_float(lw0 << 16); x[1] = __uint_as_float(hw0 & 0xffff0000u) + __uint_as_float(lw0 & 0xffff0000u);
                    x[2] = __uint_as_float(hw1 << 16) + __uint_as_float(lw1 << 16); x[3] = __uint_as_float(hw1 & 0xffff0000u) + __uint_as_float(lw1 & 0xffff0000u);
                    const f32x4 gvv = *(const PG8_LAS f32x4*)(gl + bj * HALF + n * 16), bvv = *(const PG8_LAS f32x4*)(gl + 1024 + bj * HALF + n * 16);
                    const f32x4 xn = (x * rs - ms) * gvv + bvv; const f32x4 y = xn * alpha + acc[AI][bj][m][n] * s;
                    const unsigned nh0 = cvt_pk_bf16(y[0], y[1]), nh1 = cvt_pk_bf16(y[2], y[3]);
                    f32x2 w; w.x = __uint_as_float(nh0); w.y = __uint_as_float(nh1); *(f32x2*)(PB + (ro + (unsigned)(bj * HALF + n * 16))) = w;
                    f32x2 wl; wl.x = __uint_as_float(cvt_pk_bf16(y[0] - __uint_as_float(nh0 << 16), y[1] - __uint_as_float(nh0 & 0xffff0000u))); wl.y = __uint_as_float(cvt_pk_bf16(y[2] - __uint_as_float(nh1 << 16), y[3] - __uint_as_float(nh1 & 0xffff0000u)));
                    *(f32x2*)((bf16_t*)X + ((unsigned)row * 2048u + 1024u + (unsigned)(col0 + bj * HALF + n * 16))) = wl;
                    sm += (y[0] + y[1]) + (y[2] + y[3]); sq += (y[0] * y[0] + y[1] * y[1]) + (y[2] * y[2] + y[3] * y[3]); }
            sm = xsum_rows(sm); sq = xsum_rows(sq);
            if (fq == 0) { f32x2 pr; pr.x = sm; pr.y = sq; *(PG8_LAS f32x2*)(red + ((AI * HALF + wr * 64 + m * 16 + fr) * 4 + wc) * 2) = pr; }
        }
        asm volatile("" ::: "memory");
    }
    __device__ __forceinline__ void operator()(const f32x4 (&acc)[2][2][4][2], const Unit& u, int wr, int wc, int fr, int fq, PG8_LAS unsigned char* ldsb) const {
        const int row0 = u.pm * BM + wr * 64 + fr; const int col0 = u.pn * BM + wc * 32 + 4 * fq;
        PG8_LAS float* red = (PG8_LAS float*)(ldsb + 131072);
        const PG8_LAS float* gl = (const PG8_LAS float*)(ldsb + 147456) + col0;
        batch<0, 0, 2>(acc, row0, col0, wr, wc, fr, fq, red, gl);
        batch<0, 2, 2>(acc, row0, col0, wr, wc, fr, fq, red, gl);
        batch<1, 0, 4>(acc, row0, col0, wr, wc, fr, fq, red, gl);
        asm volatile("s_waitcnt lgkmcnt(0)" ::: "memory"); __builtin_amdgcn_s_barrier(); asm volatile("" ::: "memory");
        { const int t = wr * 256 + wc * 64 + fq * 16 + fr;
          if (t < 256) { const PG8_LAS f32x4* rr = (const PG8_LAS f32x4*)(red + t * 8); const f32x4 a = rr[0], b = rr[1];
              f32x2 o; o.x = (a[0] + a[2]) + (b[0] + b[2]); o.y = (a[1] + a[3]) + (b[1] + b[3]); *(f32x2*)(stn + 8 * (size_t)(u.pm * BM + t) + 2 * u.pn) = o; } }
    }
};
struct EpiStore {
    static constexpr bool PERM = true, AFTER_DRAIN = false;
    bf16_t* O; int ldc; LnFix ln;
    __device__ __forceinline__ void operator()(const f32x4 (&acc)[2][2][4][2], const Unit& u, int wr, int wc, int fr, int fq, PG8_LAS unsigned char* ldsb) const {
        const int row0 = u.pm * BM + wr * 64 + fr; const int col0 = u.pn * BM + wc * 32 + 8 * fq;
        const bool has_ln = ln.st != nullptr;
        f32x4 c1v[2][2], c2v[2][2]; float rsv[2][4], msv[2][4];
#pragma unroll
        for (int ai = 0; ai < 2; ++ai)
#pragma unroll
            for (int m = 0; m < 4; ++m) { rsv[ai][m] = 1.f; msv[ai][m] = 0.f; }
#pragma unroll
        for (int bj = 0; bj < 2; ++bj)
#pragma unroll
            for (int n = 0; n < 2; ++n) { c1v[bj][n] = (f32x4){0.f, 0.f, 0.f, 0.f}; c2v[bj][n] = (f32x4){0.f, 0.f, 0.f, 0.f}; }
        if (has_ln) {
            const PG8_LAS unsigned* CV = (const PG8_LAS unsigned*)(ldsb + 131072);
            PG8_LAS f32x2* ST = (PG8_LAS f32x2*)(ldsb + 153600);
            volatile PG8_LAS int* TAG = (volatile PG8_LAS int*)(ldsb + 155648);
            if (TAG[wr] != u.pm) {
#pragma unroll
                for (int ai = 0; ai < 2; ++ai)
#pragma unroll
                    for (int m = 0; m < 4; ++m) { ln_row(ln.st, row0 + ai * HALF + m * 16, fq, rsv[ai][m], msv[ai][m]);
                        f32x2 pr; pr.x = rsv[ai][m]; pr.y = msv[ai][m]; ST[ai * HALF + wr * 64 + m * 16 + fr] = pr; }
                asm volatile("s_waitcnt lgkmcnt(0)" ::: "memory");
                TAG[wr] = u.pm;
            } else {
#pragma unroll
                for (int ai = 0; ai < 2; ++ai)
#pragma unroll
                    for (int m = 0; m < 4; ++m) { const f32x2 pr = ST[ai * HALF + wr * 64 + m * 16 + fr]; rsv[ai][m] = pr.x; msv[ai][m] = pr.y; }
            }
#pragma unroll
            for (int bj = 0; bj < 2; ++bj)
#pragma unroll
                for (int n = 0; n < 2; ++n) { const u32x4 cw = *(const PG8_LAS u32x4*)(CV + col0 + bj * HALF + 4 * n);
#pragma unroll
                    for (int i = 0; i < 4; ++i) { c1v[bj][n][i] = __uint_as_float(cw[i] << 16); c2v[bj][n][i] = __uint_as_float(cw[i] & 0xffff0000u); } }
        }
#pragma unroll
        for (int ai = 0; ai < 2; ++ai)
#pragma unroll
            for (int m = 0; m < 4; ++m) {
                bf16_t* rowp = O + (size_t)(row0 + ai * HALF + m * 16) * ldc + col0;
                const float rs = rsv[ai][m], ms = msv[ai][m];
#pragma unroll
                for (int bj = 0; bj < 2; ++bj) { const f32x4 v0 = acc[ai][bj][m][0] * rs - c1v[bj][0] * ms + c2v[bj][0], v1 = acc[ai][bj][m][1] * rs - c1v[bj][1] * ms + c2v[bj][1];
                    u32x4 w; w.x = cvt_pk_bf16(v0[0], v0[1]); w.y = cvt_pk_bf16(v0[2], v0[3]); w.z = cvt_pk_bf16(v1[0], v1[1]); w.w = cvt_pk_bf16(v1[2], v1[3]);
                    *(u32x4*)(rowp + bj * HALF) = w; }
            }
    }
};
struct EpiLru {
    static constexpr bool PERM = true, AFTER_DRAIN = false;
    unsigned* AB; const bf16_t* XC; const float* gb; const float* lam;
    __device__ __forceinline__ void operator()(const f32x4 (&acc)[2][2][4][2], const Unit& u, int wr, int wc, int fr, int fq, PG8_LAS unsigned char* ldsb) const {
        const int row0 = u.pm * BM + wr * 64 + fr; const int ch0 = u.pn * HALF + wc * 32 + 8 * fq;
        float sp[8], br[8], bi[8];
#pragma unroll
        for (int i = 0; i < 8; ++i) { sp[i] = lam[ch0 + i]; br[i] = gb[ch0 + i]; bi[i] = gb[512 + ch0 + i]; }
        u32x4 xwv[2][4];
#pragma unroll
        for (int ai = 0; ai < 2; ++ai)
#pragma unroll
            for (int m = 0; m < 4; ++m) xwv[ai][m] = *(const u32x4*)(XC + ((unsigned)(row0 + ai * HALF + m * 16) * 512u + (unsigned)ch0));
#pragma unroll
        for (int ai = 0; ai < 2; ++ai)
#pragma unroll
            for (int m = 0; m < 4; ++m) {
                const size_t ro = (size_t)(row0 + ai * HALF + m * 16) * 512 + ch0;
                const u32x4 xw = xwv[ai][m];
                unsigned ow[8];
#pragma unroll
                for (int n = 0; n < 2; ++n)
#pragma unroll
                    for (int i = 0; i < 4; ++i) { const int e = n * 4 + i;
                        const unsigned wd = xw[e >> 1]; const float xc = __uint_as_float((e & 1) ? (wd & 0xffff0000u) : (wd << 16));
                        const float r = fast_sigmoid(acc[ai][0][m][n][i] + br[e]), ig = fast_sigmoid(acc[ai][1][m][n][i] + bi[e]);
                        const float la = sp[e] * r;
                        const float bb = __builtin_sqrtf(fmaxf(1.0f - __expf(2.0f * la), 0.f)) * (ig * xc);
                        ow[e] = cvt_pk_bf16(la * 1.4426950408889634f, bb); }
                u32x4 w0, w1; w0.x = ow[0]; w0.y = ow[1]; w0.z = ow[2]; w0.w = ow[3]; w1.x = ow[4]; w1.y = ow[5]; w1.z = ow[6]; w1.w = ow[7];
                *(u32x4*)(AB + ro) = w0; *(u32x4*)(AB + ro + 4) = w1;
            }
    }
};
struct EpiGlu {
    static constexpr bool PERM = true, AFTER_DRAIN = false;
    bf16_t* O; int ldo; const bf16_t* Zs; const float* bias;
    __device__ __forceinline__ void operator()(const f32x4 (&acc)[2][2][4][2], const Unit& u, int wr, int wc, int fr, int fq, PG8_LAS unsigned char* ldsb) const {
        const int row0 = u.pm * BM + wr * 64 + fr; const int col0 = u.pn * BM + wc * 32 + 8 * fq;
#pragma unroll
        for (int ai = 0; ai < 2; ++ai) {
            u32x4 zv[4][2];
#pragma unroll
            for (int m = 0; m < 4; ++m)
#pragma unroll
                for (int bj = 0; bj < 2; ++bj) zv[m][bj] = *(const u32x4*)(Zs + ((unsigned)(row0 + ai * HALF + m * 16) * 512u + (unsigned)(col0 + bj * HALF)));
#pragma unroll
            for (int m = 0; m < 4; ++m) {
                const int row = row0 + ai * HALF + m * 16;
#pragma unroll
                for (int bj = 0; bj < 2; ++bj) {
                    const int c = col0 + bj * HALF;
                    const u32x4 zw = zv[m][bj];
                    float v[8];
#pragma unroll
                    for (int n = 0; n < 2; ++n)
#pragma unroll
                        for (int i = 0; i < 4; ++i) { const int e = n * 4 + i; const unsigned wd = zw[e >> 1];
                            const float z = __uint_as_float((e & 1) ? (wd & 0xffff0000u) : (wd << 16));
                            v[e] = z * fast_sigmoid(acc[ai][bj][m][n][i] + bias[c + e]); }
                    u32x4 w; w.x = cvt_pk_bf16(v[0], v[1]); w.y = cvt_pk_bf16(v[2], v[3]); w.z = cvt_pk_bf16(v[4], v[5]); w.w = cvt_pk_bf16(v[6], v[7]);
                    *(u32x4*)(O + (size_t)row * ldo + c) = w;
                }
            }
            asm volatile("" ::: "memory");
        }
    }
};
template <class Epi, class Sched, bool ALIGN_EPI = false, bool SP2 = false>
__device__ __forceinline__ void gemm_phase(PG8_LAS unsigned char* lds, const Gemm g, const Sched& S, const Epi& E) {
    int tid_ = threadIdx.x; asm volatile("" : "+v"(tid_)); const int tid = tid_, wid = __builtin_amdgcn_readfirstlane(tid >> 6), lane = tid & 63, wr = wid >> 2, wc = wid & 3, fr = lane & 15, fq = lane >> 4;
    const bf16_t* gA_ = g.A; const bf16_t* gB_ = g.Bt; int K = g.K; asm volatile("" : "+s"(gA_), "+s"(gB_), "+s"(K)); const int nt = K / BK;
    unsigned voffA[2], voffB[2];
#pragma unroll
    for (int i = 0; i < 2; ++i) { int R, C; stage_rc(tid * 16 + i * 8192, R, C); const int Rb = Epi::PERM ? ((R & ~31) + perm32(R & 31)) : R;
        voffA[i] = (unsigned)(R * K + C) * 2u; voffB[i] = (unsigned)(Rb * K + C) * 2u; }
    const size_t kstep = (size_t)(BK * 2);
    const size_t hstep = (size_t)HALF * K * 2;
    const size_t tstep = 2 * hstep;
    const unsigned ldsw = (unsigned)wid * 1024u;
    const int aoff = lds_byte(wr * 64 + fr, fq * 8), boff = lds_byte(wc * 32 + fr, fq * 8);
#define PG8_SA(b, h) (((b) * 2 + (h)) * HTB)
#define PG8_SB(b, h) ((4 + (b) * 2 + (h)) * HTB)
#define PG8_STAGE(bufoff, gbase, voff) do { _Pragma("unroll") for (int _i = 0; _i < 2; ++_i) \
        __builtin_amdgcn_global_load_lds((const unsigned*)((const char*)(gbase) + (voff)[_i]), (PG8_LAS unsigned*)(lds + (bufoff) + ldsw + _i * 8192), 16, 0, 0); } while (0)
#define PG8_LDA(dst, b, h) do { _Pragma("unroll") for (int m = 0; m < 4; ++m) _Pragma("unroll") for (int k = 0; k < 2; ++k) dst[m][k] = *(const PG8_LAS bf16x8*)(lds + PG8_SA(b, h) + aoff + m * 2048 + k * 1024); } while (0)
#define PG8_LDB(dst, b, h) do { _Pragma("unroll") for (int n = 0; n < 2; ++n) _Pragma("unroll") for (int k = 0; k < 2; ++k) dst[n][k] = *(const PG8_LAS bf16x8*)(lds + PG8_SB(b, h) + boff + n * 2048 + k * 1024); } while (0)
#define PG8_MMA(ai, bj, At, Bt) do { __builtin_amdgcn_s_setprio(1); _Pragma("unroll") for (int m = 0; m < 4; ++m) _Pragma("unroll") for (int n = 0; n < 2; ++n) _Pragma("unroll") for (int k = 0; k < 2; ++k) \
        acc[ai][bj][m][n] = __builtin_amdgcn_mfma_f32_16x16x32_bf16(Bt[n][k], At[m][k], acc[ai][bj][m][n], 0, 0, 0); __builtin_amdgcn_s_setprio(0); } while (0)
#define PG8_WAIT_V(n) asm volatile("s_waitcnt vmcnt(" #n ")" ::: "memory")
#define PG8_WAIT_L(n) asm volatile("s_waitcnt lgkmcnt(" #n ")" ::: "memory")
#define PG8_BAR __builtin_amdgcn_s_barrier()
#define PG8_SCHED __builtin_amdgcn_sched_barrier(0)
    Unit cur, nxt; int ui = 0;
    if (!S.next(0, cur)) return;
    f32x4 acc[2][2][4][2];
#pragma unroll
    for (int a = 0; a < 2; ++a)
#pragma unroll
        for (int b = 0; b < 2; ++b)
#pragma unroll
            for (int m = 0; m < 4; ++m)
#pragma unroll
                for (int n = 0; n < 2; ++n) acc[a][b][m][n] = (f32x4){0.f, 0.f, 0.f, 0.f};
    bf16x8 At[4][2], B0[2][2], B1[2][2];
    const char* cA = (const char*)gA_ + (size_t)cur.pm * tstep; const char* cB = (const char*)gB_ + (size_t)cur.pn * tstep;
    S.a_ready(cur);
    if constexpr (SP2) {
        PG8_STAGE(PG8_SB(0, 0), cB, voffB); PG8_STAGE(PG8_SB(0, 1), cB + hstep, voffB); PG8_STAGE(PG8_SA(0, 0), cA, voffA); PG8_STAGE(PG8_SA(0, 1), cA + hstep, voffA);
        if (wr == 1) PG8_BAR;
        PG8_WAIT_V(2); PG8_BAR;
        PG8_STAGE(PG8_SB(1, 0), cB + kstep, voffB); PG8_STAGE(PG8_SA(1, 0), cA + kstep, voffA); PG8_STAGE(PG8_SB(1, 1), cB + hstep + kstep, voffB);
        PG8_WAIT_V(6); PG8_BAR;
    } else {
        PG8_STAGE(PG8_SB(0, 0), cB, voffB); PG8_STAGE(PG8_SA(0, 0), cA, voffA); PG8_STAGE(PG8_SB(0, 1), cB + hstep, voffB); PG8_STAGE(PG8_SA(0, 1), cA + hstep, voffA);
        if (wr == 1) PG8_BAR;
        PG8_WAIT_V(4); PG8_BAR;
        PG8_STAGE(PG8_SB(1, 0), cB + kstep, voffB); PG8_STAGE(PG8_SA(1, 0), cA + kstep, voffA); PG8_STAGE(PG8_SB(1, 1), cB + hstep + kstep, voffB);
        PG8_WAIT_V(6); PG8_BAR;
    }
    for (;;) {
        const bool has_next = S.next(ui + 1, nxt);
        const char* nA = has_next ? (const char*)gA_ + (size_t)nxt.pm * tstep : cA; const char* nB = has_next ? (const char*)gB_ + (size_t)nxt.pn * tstep : cB;
        for (int t = 0; t < nt; t += 2) {
            const bool last = (t == nt - 2);
            const char* a1 = cA + (size_t)(t + 1) * kstep;
            const char* a2 = last ? nA : cA + (size_t)(t + 2) * kstep; const char* b2 = last ? nB : cB + (size_t)(t + 2) * kstep;
            const char* a3 = a2 + kstep; const char* b3 = b2 + kstep;
            if (last && has_next) S.a_ready(nxt);
            if constexpr (SP2) {
            PG8_LDB(B0, 0, 0); PG8_LDB(B1, 0, 1); PG8_SCHED; PG8_LDA(At, 0, 0); PG8_STAGE(PG8_SA(1, 1), a1 + hstep, voffA);
            PG8_WAIT_V(8); PG8_WAIT_L(0); PG8_BAR; PG8_MMA(0, 0, At, B0); PG8_MMA(0, 1, At, B1); PG8_BAR; PG8_SCHED;
            PG8_LDA(At, 0, 1); PG8_STAGE(PG8_SB(0, 0), b2, voffB); PG8_STAGE(PG8_SB(0, 1), b2 + hstep, voffB); PG8_STAGE(PG8_SA(0, 0), a2, voffA);
            PG8_WAIT_V(8); PG8_WAIT_L(0); PG8_BAR; PG8_MMA(1, 0, At, B0); PG8_MMA(1, 1, At, B1); PG8_BAR; PG8_SCHED;
            PG8_LDB(B0, 1, 0); PG8_LDB(B1, 1, 1); PG8_SCHED; PG8_LDA(At, 1, 0); PG8_STAGE(PG8_SA(0, 1), a2 + hstep, voffA);
            PG8_WAIT_V(8); PG8_WAIT_L(0); PG8_BAR; PG8_MMA(0, 0, At, B0); PG8_MMA(0, 1, At, B1); PG8_BAR; PG8_SCHED;
            PG8_LDA(At, 1, 1); PG8_STAGE(PG8_SB(1, 0), b3, voffB); PG8_STAGE(PG8_SB(1, 1), b3 + hstep, voffB); PG8_STAGE(PG8_SA(1, 0), a3, voffA);
            PG8_WAIT_V(8); PG8_WAIT_L(0); PG8_BAR; PG8_MMA(1, 0, At, B0); PG8_MMA(1, 1, At, B1); PG8_BAR; PG8_SCHED;
            } else {
            PG8_LDB(B0, 0, 0); PG8_SCHED; PG8_LDA(At, 0, 0); PG8_STAGE(PG8_SA(1, 1), a1 + hstep, voffA);
            PG8_WAIT_L(8); PG8_BAR; PG8_WAIT_L(0); PG8_MMA(0, 0, At, B0); PG8_BAR; PG8_SCHED;
            PG8_LDB(B1, 0, 1); PG8_STAGE(PG8_SB(0, 0), b2, voffB);
            PG8_BAR; PG8_WAIT_L(0); PG8_MMA(0, 1, At, B1); PG8_BAR;
            PG8_LDA(At, 0, 1); PG8_STAGE(PG8_SA(0, 0), a2, voffA);
            PG8_BAR; PG8_WAIT_L(0); PG8_MMA(1, 0, At, B0); PG8_BAR; PG8_SCHED;
            PG8_STAGE(PG8_SB(0, 1), b2 + hstep, voffB);
            PG8_WAIT_V(6); PG8_BAR; PG8_MMA(1, 1, At, B1); PG8_BAR;
            PG8_LDB(B0, 1, 0); PG8_SCHED; PG8_LDA(At, 1, 0); PG8_STAGE(PG8_SA(0, 1), a2 + hstep, voffA);
            PG8_WAIT_L(8); PG8_BAR; PG8_WAIT_L(0); PG8_MMA(0, 0, At, B0); PG8_BAR; PG8_SCHED;
            PG8_LDB(B1, 1, 1); PG8_STAGE(PG8_SB(1, 0), b3, voffB);
            PG8_BAR; PG8_WAIT_L(0); PG8_MMA(0, 1, At, B1); PG8_BAR;
            PG8_LDA(At, 1, 1); PG8_STAGE(PG8_SA(1, 0), a3, voffA);
            PG8_BAR; PG8_WAIT_L(0); PG8_MMA(1, 0, At, B0); PG8_BAR; PG8_SCHED;
            PG8_STAGE(PG8_SB(1, 1), b3 + hstep, voffB);
            PG8_WAIT_V(6); PG8_BAR; PG8_MMA(1, 1, At, B1); PG8_BAR;
            }
        }
        if constexpr (ALIGN_EPI) { if (wr == 0) PG8_BAR; }
        if constexpr (!Epi::AFTER_DRAIN) { E(acc, cur, wr, wc, fr, fq, lds); S.done(cur); }
        if (!has_next) break;
#pragma unroll
        for (int a = 0; a < 2; ++a)
#pragma unroll
            for (int b = 0; b < 2; ++b)
#pragma unroll
                for (int m = 0; m < 4; ++m)
#pragma unroll
                    for (int n = 0; n < 2; ++n) acc[a][b][m][n] = (f32x4){0.f, 0.f, 0.f, 0.f};
        cur = nxt; cA = nA; cB = nB; ++ui;
        if constexpr (ALIGN_EPI) { if (wr == 1) PG8_BAR; }
    }
    PG8_WAIT_V(0);
    if constexpr (!ALIGN_EPI) { if (wr == 0) PG8_BAR; }
    PG8_BAR;
    if constexpr (Epi::AFTER_DRAIN) { E.fused(acc, cur, wr, wc, fr, fq, lds, wid, lane); S.done(cur); }
#undef PG8_SA
#undef PG8_SB
#undef PG8_STAGE
#undef PG8_LDA
#undef PG8_LDB
#undef PG8_MMA
#undef PG8_WAIT_V
#undef PG8_WAIT_L
#undef PG8_BAR
#undef PG8_SCHED
}
}
#define LAS __attribute__((address_space(3)))
typedef unsigned short bf16_t;
typedef short bf16x8 __attribute__((ext_vector_type(8)));
typedef float f32x4 __attribute__((ext_vector_type(4)));
typedef float f32x2 __attribute__((ext_vector_type(2)));
typedef unsigned u32x4 __attribute__((ext_vector_type(4)));
using pg8::cvt_pk_bf16;

constexpr int T_TOK = 65536, DM = 1024, SEQ = 2048, NBATCH = 32, DFF = 2816, ZW = 2560, MEMT = 8192;
constexpr float DN_ALPHA = 1.681792830507429f, LN_EPS = 1e-5f, LOG2E = 1.4426950408889634f;
constexpr size_t SZ_W1 = (size_t)5632 * 1024, SZ_W2 = (size_t)1024 * 2816;
constexpr size_t OFF_W1 = 0, OFF_W2 = 2 * SZ_W1, OFF_WQ = OFF_W2 + 2 * SZ_W2, OFF_WKV = OFF_WQ + 1048576, OFF_WO = OFF_WKV + 2097152,
                 OFF_WIN = OFF_WO + 1048576, OFF_WOUT = OFF_WIN + 2621440, OFF_WEX = OFF_WOUT + 1048576, LAYER_W = OFF_WEX + 524288;
static_assert(LAYER_W * 2 == (size_t)49 << 20, "layer weights = 49 MiB");
constexpr size_t MiB = 1u << 20;
constexpr size_t WS_STATS = 1016 * MiB, WS_CVEC = 198 * MiB, WS_ONES = 198 * MiB + 786432, WS_ZEROS = 198 * MiB + 790528, CVEC_STRIDE = 2 * 5632, WS_SPL = 1 * MiB + 917504, WS_ROPE_DA = 1 * MiB, WS_ROPE_RET = 1 * MiB + 131072, WS_W = 2 * MiB, WS_MEMB = 200 * MiB, WS_XB = 216 * MiB, WS_BIG = 344 * MiB,
                 WS_CAT = 696 * MiB, WS_AUX = 824 * MiB, WS_AUX2 = 952 * MiB, WS_END = 1024 * MiB;
constexpr int LDS_BYTES = 156160;

struct Params { const float* in[32]; float* out; unsigned char* ws; };

__device__ __forceinline__ float bflo(unsigned w) { return __uint_as_float(w << 16); }
__device__ __forceinline__ float bfhi(unsigned w) { return __uint_as_float(w & 0xffff0000u); }
__device__ __forceinline__ unsigned short f2bf(float f) { return (unsigned short)(cvt_pk_bf16(f, 0.f) & 0xffffu); }
__device__ __forceinline__ float gelu_tanh(float x) { const float t = 1.5957691216057308f * (x + 0.044715f * x * x * x); return x * __builtin_amdgcn_rcpf(1.0f + __expf(-t)); }
__device__ __forceinline__ float silu_f(float x) { return x * __builtin_amdgcn_rcpf(1.0f + __expf(-x)); }
#define WSYNC() asm volatile("s_waitcnt lgkmcnt(0)" ::: "memory")
__device__ __forceinline__ float wave_sum(float v) {
    int self = (int)__builtin_amdgcn_mbcnt_hi(~0u, __builtin_amdgcn_mbcnt_lo(~0u, 0u)); asm volatile("" : "+v"(self));
#pragma unroll
    for (int o = 1; o < 16; o <<= 1) v += __int_as_float(__builtin_amdgcn_ds_bpermute((self ^ o) << 2, __float_as_int(v)));
    return xsum_rows(v);
}
__device__ __forceinline__ float red16(float v) { v += __shfl_xor(v, 1); v += __shfl_xor(v, 2); v += __shfl_xor(v, 4); v += __shfl_xor(v, 8); return v; }
__device__ __forceinline__ float max16(float v) { v = fmaxf(v, __shfl_xor(v, 1)); v = fmaxf(v, __shfl_xor(v, 2)); v = fmaxf(v, __shfl_xor(v, 4)); v = fmaxf(v, __shfl_xor(v, 8)); return v; }
__device__ __forceinline__ void sincos_acc(float angf, float& s, float& c) {
    const double x = (double)angf; const double k = rint(x * 0.15915494309189535); const double r = fma(-k, 6.283185307179586, x);
    const double r2 = r * r; double ts = r, tc = 1.0, ss = r, cc = 1.0;
#pragma unroll
    for (int n = 1; n <= 14; ++n) { tc *= -r2 * (1.0 / (double)((2 * n - 1) * (2 * n))); cc += tc; ts *= -r2 * (1.0 / (double)((2 * n) * (2 * n + 1))); ss += ts; }
    s = (float)ss; c = (float)cc;
}

__device__ __forceinline__ void transpose_mat(const float* W, int K, int N, bf16_t* WT, int mode, int row_off, LAS float* scr, int gw, int NGW, int lane, int& base_item, const float* gs = nullptr) {
    const int nblk = N / 32, items = (K / 64) * nblk;
    int first = (gw - (base_item % NGW) + NGW) % NGW;
    for (int item = first; item < items; item += NGW) {
        const int kb = item / nblk, nb = item % nblk, k0 = 64 * kb, n0 = 32 * nb;
        const int rowbase = mode ? ((n0 >> 7) * 256 + row_off + (n0 & 127)) : (row_off + n0);
#pragma unroll
        for (int i = 0; i < 32; ++i) { const int kk = 2 * i + (lane >> 5); const float sc_ = gs ? gs[k0 + kk] : 1.0f; scr[kk * 33 + (lane & 31)] = W[(size_t)(k0 + kk) * N + n0 + (lane & 31)] * sc_; }
        WSYNC();
        const int c = lane & 7;
#pragma unroll
        for (int j = 0; j < 4; ++j) { const int n = (lane >> 3) + 8 * j; const LAS float* s = scr + (8 * c) * 33 + n;
            u32x4 o; o.x = cvt_pk_bf16(s[0 * 33], s[1 * 33]); o.y = cvt_pk_bf16(s[2 * 33], s[3 * 33]); o.z = cvt_pk_bf16(s[4 * 33], s[5 * 33]); o.w = cvt_pk_bf16(s[6 * 33], s[7 * 33]);
            *(u32x4*)(WT + (size_t)(rowbase + n) * K + k0 + 8 * c) = o; }
        WSYNC();
    }
    base_item += items;
}

typedef unsigned u32x2 __attribute__((ext_vector_type(2)));
template <int D, int DV, int MODE, int NMAP>
__device__ __forceinline__ void attn_core2(LAS unsigned char* lds, const bf16_t* Qp, int ldq, const bf16_t* Kp, int ldk, const bf16_t* Vp, int ldv,
                                           int q0, int nkt, float sc, float l2g, f32x4 (&o)[NMAP][DV / 16], float (&l)[NMAP]) {
    constexpr int DT = NMAP * D, KSTR = DT + 8, VSTR = 72, KS_BYTES = 64 * KSTR * 2, KN = DT / 64, VN = DV / 64;
    int tid_ = threadIdx.x; asm volatile("" : "+v"(tid_)); const int tid = tid_, lane = tid & 63, w = __builtin_amdgcn_readfirstlane(tid >> 6), r = lane & 15, g4 = lane >> 4;
    LAS bf16_t* Ks = (LAS bf16_t*)lds; LAS bf16_t* Vt = (LAS bf16_t*)(lds + KS_BYTES);
    bf16x8 qf[NMAP][D / 32];
    { const bf16_t* qr = Qp + (size_t)(w * 16 + r) * ldq + g4 * 8;
#pragma unroll
      for (int mp = 0; mp < NMAP; ++mp)
#pragma unroll
        for (int kk = 0; kk < D / 32; ++kk) qf[mp][kk] = *(const bf16x8*)(qr + mp * D + kk * 32); }
    float m[NMAP];
#pragma unroll
    for (int mp = 0; mp < NMAP; ++mp) { m[mp] = -INFINITY; l[mp] = 0.f;
#pragma unroll
        for (int cb = 0; cb < DV / 16; ++cb) o[mp][cb] = (f32x4){0.f, 0.f, 0.f, 0.f}; }
    const int rowmin = q0 + w * 16, myrow = rowmin + r;
    u32x4 kreg[KN], vreg[VN];
#pragma unroll
    for (int i = 0; i < KN; ++i) { const int c = tid + i * 512; const int key = c / (DT / 8), ch = c % (DT / 8); kreg[i] = *(const u32x4*)(Kp + (size_t)key * ldk + ch * 8); }
#pragma unroll
    for (int i = 0; i < VN; ++i) { const int c = w + i * 8; vreg[i] = *(const u32x4*)(Vp + (size_t)lane * ldv + c * 8); }
    for (int kt = 0; kt < nkt; ++kt) {
        __syncthreads();
#pragma unroll
        for (int i = 0; i < KN; ++i) { const int c = tid + i * 512; const int key = c / (DT / 8), ch = c % (DT / 8); *(LAS u32x4*)(Ks + key * KSTR + ch * 8) = kreg[i]; }
#pragma unroll
        for (int i = 0; i < VN; ++i) { const int c = w + i * 8; const u32x4 v = vreg[i];
            LAS bf16_t* d = Vt + (c * 8) * VSTR + lane;
            d[0 * VSTR] = (bf16_t)(v.x & 0xffffu); d[1 * VSTR] = (bf16_t)(v.x >> 16); d[2 * VSTR] = (bf16_t)(v.y & 0xffffu); d[3 * VSTR] = (bf16_t)(v.y >> 16);
            d[4 * VSTR] = (bf16_t)(v.z & 0xffffu); d[5 * VSTR] = (bf16_t)(v.z >> 16); d[6 * VSTR] = (bf16_t)(v.w & 0xffffu); d[7 * VSTR] = (bf16_t)(v.w >> 16); }
        __syncthreads();
        if (kt + 1 < nkt) {
#pragma unroll
            for (int i = 0; i < KN; ++i) { const int c = tid + i * 512; const int key = c / (DT / 8), ch = c % (DT / 8); kreg[i] = *(const u32x4*)(Kp + (size_t)((kt + 1) * 64 + key) * ldk + ch * 8); }
#pragma unroll
            for (int i = 0; i < VN; ++i) { const int c = w + i * 8; vreg[i] = *(const u32x4*)(Vp + (size_t)((kt + 1) * 64 + lane) * ldv + c * 8); }
        }
        if (MODE == 0 || kt * 64 <= rowmin + 15) {
            bf16x8 pb[NMAP][2];
#pragma unroll
            for (int mp = 0; mp < NMAP; ++mp) {
                f32x4 s[4];
#pragma unroll
                for (int nb = 0; nb < 4; ++nb) { s[nb] = (f32x4){0.f, 0.f, 0.f, 0.f};
#pragma unroll
                    for (int kk = 0; kk < D / 32; ++kk) { const bf16x8 kf = *(const LAS bf16x8*)(Ks + (nb * 16 + r) * KSTR + mp * D + kk * 32 + g4 * 8);
                        s[nb] = __builtin_amdgcn_mfma_f32_16x16x32_bf16(kf, qf[mp][kk], s[nb], 0, 0, 0); } }
                if (MODE < 2) {
                    float mx = -INFINITY;
#pragma unroll
                    for (int nb = 0; nb < 4; ++nb)
#pragma unroll
                        for (int j = 0; j < 4; ++j) { float x = s[nb][j] * sc;
                            if (MODE == 1) { const int key = kt * 64 + nb * 16 + g4 * 4 + j; if (key > myrow) x = -INFINITY; }
                            s[nb][j] = x; mx = fmaxf(mx, x); }
                    mx = xmax_rows(mx);
                    const float mn = fmaxf(m[mp], mx); const float al = __builtin_amdgcn_exp2f(m[mp] - mn); m[mp] = mn;
                    float ps = 0.f;
#pragma unroll
                    for (int nb = 0; nb < 4; ++nb)
#pragma unroll
                        for (int j = 0; j < 4; ++j) { const float p = __builtin_amdgcn_exp2f(s[nb][j] - mn); ps += p; s[nb][j] = p; }
                    l[mp] = l[mp] * al + ps;
#pragma unroll
                    for (int cb = 0; cb < DV / 16; ++cb) o[mp][cb] = o[mp][cb] * al;
                } else {
#pragma unroll
                    for (int nb = 0; nb < 4; ++nb)
#pragma unroll
                        for (int j = 0; j < 4; ++j) { const int dd = myrow - (kt * 64 + nb * 16 + g4 * 4 + j);
                            s[nb][j] = dd >= 0 ? s[nb][j] * __builtin_amdgcn_exp2f(l2g * (float)dd) : 0.f; }
                }
#pragma unroll
                for (int kk = 0; kk < 2; ++kk) { u32x4 wv; wv.x = cvt_pk_bf16(s[2 * kk][0], s[2 * kk][1]); wv.y = cvt_pk_bf16(s[2 * kk][2], s[2 * kk][3]);
                    wv.z = cvt_pk_bf16(s[2 * kk + 1][0], s[2 * kk + 1][1]); wv.w = cvt_pk_bf16(s[2 * kk + 1][2], s[2 * kk + 1][3]); pb[mp][kk] = __builtin_bit_cast(bf16x8, wv); }
            }
#pragma unroll
            for (int kk = 0; kk < 2; ++kk)
#pragma unroll
                for (int cb = 0; cb < DV / 16; ++cb) { const LAS bf16_t* vp = Vt + (cb * 16 + r) * VSTR + kk * 32 + g4 * 4;
                    const u32x2 lo = *(const LAS u32x2*)vp, hi = *(const LAS u32x2*)(vp + 16); u32x4 t; t.x = lo.x; t.y = lo.y; t.z = hi.x; t.w = hi.y;
                    const bf16x8 vf = __builtin_bit_cast(bf16x8, t);
#pragma unroll
                    for (int mp = 0; mp < NMAP; ++mp) o[mp][cb] = __builtin_amdgcn_mfma_f32_16x16x32_bf16(vf, pb[mp][kk], o[mp][cb], 0, 0, 0); }
        }
    }
    if (MODE < 2) {
#pragma unroll
        for (int mp = 0; mp < NMAP; ++mp) { l[mp] = xsum_rows(l[mp]); }
    }
}

template <int D, int DV, int MODE, int NMAP, int KT>
__device__ __forceinline__ void attn_core3(LAS unsigned char* lds, const bf16_t* Qp, int ldq, const bf16_t* Kp, int ldk, const bf16_t* Vp, int ldv,
                                           int q0, int nkt, float sc, float l2g, f32x4 (&o)[NMAP][DV / 16], float (&l)[NMAP]) {
    constexpr int DT = NMAP * D, KSTR = DT + 8, VSTR = KT + 8, KS_BYTES = KT * KSTR * 2, VT_BYTES = DV * VSTR * 2, BUF_BYTES = KS_BYTES + VT_BYTES, KN = KT * (DT / 8) / 512, VN = (DV / 8) * (KT / 64) / 8, NB = KT / 16, KK2 = KT / 32;
    int tid_ = threadIdx.x; asm volatile("" : "+v"(tid_)); const int tid = tid_, lane = tid & 63, w = __builtin_amdgcn_readfirstlane(tid >> 6), r = lane & 15, g4 = lane >> 4;
    bf16x8 qf[NMAP][D / 32];
    { const bf16_t* qr = Qp + (size_t)(w * 16 + r) * ldq + g4 * 8;
#pragma unroll
      for (int mp = 0; mp < NMAP; ++mp)
#pragma unroll
        for (int kk = 0; kk < D / 32; ++kk) qf[mp][kk] = *(const bf16x8*)(qr + mp * D + kk * 32); }
    float m[NMAP];
#pragma unroll
    for (int mp = 0; mp < NMAP; ++mp) { m[mp] = -INFINITY; l[mp] = 0.f;
#pragma unroll
        for (int cb = 0; cb < DV / 16; ++cb) o[mp][cb] = (f32x4){0.f, 0.f, 0.f, 0.f}; }
    const int rowmin = q0 + w * 16, myrow = rowmin + r;
    float ck[NB][4];
    if (MODE == 2) {
#pragma unroll
        for (int nb = 0; nb < NB; ++nb)
#pragma unroll
            for (int j = 0; j < 4; ++j) ck[nb][j] = __builtin_amdgcn_exp2f(-l2g * (float)(nb * 16 + g4 * 4 + j));
    }
    u32x4 kreg[KN], vreg[VN];
#define AT_LOAD(t) do { _Pragma("unroll") for (int i = 0; i < KN; ++i) { const int c = tid + i * 512; const int key = c / (DT / 8), ch = c % (DT / 8); kreg[i] = *(const u32x4*)(Kp + (size_t)((t) * KT + key) * ldk + ch * 8); } \
        _Pragma("unroll") for (int i = 0; i < VN; ++i) { const int it_ = w + i * 8; const int c = it_ % (DV / 8), kg = it_ / (DV / 8); vreg[i] = *(const u32x4*)(Vp + (size_t)((t) * KT + kg * 64 + lane) * ldv + c * 8); } } while (0)
#define AT_STORE(boff) do { LAS bf16_t* Ks_ = (LAS bf16_t*)(lds + (boff)); LAS bf16_t* Vt_ = (LAS bf16_t*)(lds + (boff) + KS_BYTES); \
        _Pragma("unroll") for (int i = 0; i < KN; ++i) { const int c = tid + i * 512; const int key = c / (DT / 8), ch = c % (DT / 8); *(LAS u32x4*)(Ks_ + key * KSTR + ch * 8) = kreg[i]; } \
        _Pragma("unroll") for (int i = 0; i < VN; ++i) { const int it_ = w + i * 8; const int c = it_ % (DV / 8), kg = it_ / (DV / 8); const u32x4 v = vreg[i]; LAS bf16_t* d = Vt_ + (c * 8) * VSTR + kg * 64 + lane; \
            d[0 * VSTR] = (bf16_t)(v.x & 0xffffu); d[1 * VSTR] = (bf16_t)(v.x >> 16); d[2 * VSTR] = (bf16_t)(v.y & 0xffffu); d[3 * VSTR] = (bf16_t)(v.y >> 16); \
            d[4 * VSTR] = (bf16_t)(v.z & 0xffffu); d[5 * VSTR] = (bf16_t)(v.z >> 16); d[6 * VSTR] = (bf16_t)(v.w & 0xffffu); d[7 * VSTR] = (bf16_t)(v.w >> 16); } } while (0)
#define AT_BAR() asm volatile("s_waitcnt lgkmcnt(0)\n\ts_barrier" ::: "memory")
    AT_LOAD(0);
    AT_BAR();
    AT_STORE(0);
    if (nkt > 1) AT_LOAD(1);
    for (int kt = 0; kt < nkt; ++kt) {
        AT_BAR();
        const int cur = (kt & 1) * BUF_BYTES;
        const bool stage_first = (w < 4);
        if (stage_first && kt + 1 < nkt) { AT_STORE(((kt + 1) & 1) * BUF_BYTES); if (kt + 2 < nkt) AT_LOAD(kt + 2); }
        if (MODE == 0 || kt * KT <= rowmin + 15) {
            const LAS bf16_t* Ks = (const LAS bf16_t*)(lds + cur); const LAS bf16_t* Vt = (const LAS bf16_t*)(lds + cur + KS_BYTES);
            const bool diag = (MODE != 0) && (kt * KT + KT - 1 > rowmin);
            bf16x8 pb[NMAP][KK2];
            f32x4 sall[NMAP][NB];
#pragma unroll
            for (int mp = 0; mp < NMAP; ++mp) {
                f32x4 (&s)[NB] = sall[mp];
                constexpr int KD = D / 32, NBB = (KD >= 8) ? 1 : (8 / KD), NSB = NB / NBB;
                bf16x8 kfr[2][NBB][KD];
#define AT_SLOAD(bi_, sl_) do { _Pragma("unroll") for (int x_ = 0; x_ < NBB; ++x_) _Pragma("unroll") for (int kk = 0; kk < KD; ++kk) \
                    kfr[sl_][x_][kk] = *(const LAS bf16x8*)(Ks + (((bi_) * NBB + x_) * 16 + r) * KSTR + mp * D + kk * 32 + g4 * 8); } while (0)
                AT_SLOAD(0, 0);
#pragma unroll
                for (int bi = 0; bi < NSB; ++bi) {
                    if (bi + 1 < NSB) AT_SLOAD(bi + 1, (bi + 1) & 1);
                    __builtin_amdgcn_sched_barrier(0);
                    __builtin_amdgcn_s_setprio(1);
#pragma unroll
                    for (int x_ = 0; x_ < NBB; ++x_) { const int nb = bi * NBB + x_;
                        s[nb] = __builtin_amdgcn_mfma_f32_16x16x32_bf16(kfr[bi & 1][x_][0], qf[mp][0], (f32x4){0.f, 0.f, 0.f, 0.f}, 0, 0, 0);
#pragma unroll
                        for (int kk = 1; kk < KD; ++kk) s[nb] = __builtin_amdgcn_mfma_f32_16x16x32_bf16(kfr[bi & 1][x_][kk], qf[mp][kk], s[nb], 0, 0, 0); }
                    __builtin_amdgcn_s_setprio(0);
                    __builtin_amdgcn_sched_barrier(0);
                }
#undef AT_SLOAD
            }
#pragma unroll
            for (int mp = 0; mp < NMAP; ++mp) {
                f32x4 (&s)[NB] = sall[mp];
                if (MODE < 2) {
                    if (diag) {
#pragma unroll
                        for (int nb = 0; nb < NB; ++nb)
#pragma unroll
                            for (int j = 0; j < 4; ++j) { if (kt * KT + nb * 16 + g4 * 4 + j > myrow) s[nb][j] = -INFINITY; }
                    }
                    float mx = fmaxf(fmaxf(s[0][0], s[0][1]), s[0][2]);
                    mx = fmaxf(fmaxf(mx, s[0][3]), s[1][0]); mx = fmaxf(fmaxf(mx, s[1][1]), s[1][2]); mx = fmaxf(fmaxf(mx, s[1][3]), s[2][0]);
                    mx = fmaxf(fmaxf(mx, s[2][1]), s[2][2]); mx = fmaxf(fmaxf(mx, s[2][3]), s[3][0]); mx = fmaxf(fmaxf(mx, s[3][1]), s[3][2]); mx = fmaxf(mx, s[3][3]);
#pragma unroll
                    for (int nb = 4; nb < NB; ++nb) { mx = fmaxf(fmaxf(mx, s[nb][0]), s[nb][1]); mx = fmaxf(fmaxf(mx, s[nb][2]), s[nb][3]); }
                    mx = xmax_rows(mx) * sc;
                    if (__any(mx > m[mp] + 6.0f)) {
                        const float mn = fmaxf(m[mp], mx); const float al = __builtin_amdgcn_exp2f(m[mp] - mn); m[mp] = mn; l[mp] *= al;
#pragma unroll
                        for (int cb = 0; cb < DV / 16; ++cb) o[mp][cb] = o[mp][cb] * al;
                    }
                    const float nm = -m[mp]; float ps = 0.f;
#pragma unroll
                    for (int nb = 0; nb < NB; ++nb)
#pragma unroll
                        for (int j = 0; j < 4; ++j) { const float p = __builtin_amdgcn_exp2f(fmaf(s[nb][j], sc, nm)); ps += p; s[nb][j] = p; }
                    l[mp] += ps;
                } else {
                    const float rowf = __builtin_amdgcn_exp2f(l2g * (float)(myrow - kt * KT));
#pragma unroll
                    for (int nb = 0; nb < NB; ++nb)
#pragma unroll
                        for (int j = 0; j < 4; ++j) { float p = s[nb][j] * (rowf * ck[nb][j]); if (diag && (kt * KT + nb * 16 + g4 * 4 + j > myrow)) p = 0.f; s[nb][j] = p; }
                }
#pragma unroll
                for (int kk = 0; kk < KK2; ++kk) { u32x4 wv; wv.x = cvt_pk_bf16(s[2 * kk][0], s[2 * kk][1]); wv.y = cvt_pk_bf16(s[2 * kk][2], s[2 * kk][3]);
                    wv.z = cvt_pk_bf16(s[2 * kk + 1][0], s[2 * kk + 1][1]); wv.w = cvt_pk_bf16(s[2 * kk + 1][2], s[2 * kk + 1][3]); pb[mp][kk] = __builtin_bit_cast(bf16x8, wv); }
            }
            {
                constexpr int CBB = 4, NCB = (DV / 16) / CBB, NVB = KK2 * NCB;
                bf16x8 vfr[2][CBB];
#define AT_VLOAD(b_, sl_) do { const int kk_ = (b_) / NCB, c0_ = ((b_) % NCB) * CBB; _Pragma("unroll") for (int x_ = 0; x_ < CBB; ++x_) { const LAS bf16_t* vp = Vt + ((c0_ + x_) * 16 + r) * VSTR + kk_ * 32 + g4 * 4; \
                    const u32x2 lo = *(const LAS u32x2*)vp, hi = *(const LAS u32x2*)(vp + 16); u32x4 t; t.x = lo.x; t.y = lo.y; t.z = hi.x; t.w = hi.y; vfr[sl_][x_] = __builtin_bit_cast(bf16x8, t); } } while (0)
                AT_VLOAD(0, 0);
#pragma unroll
                for (int b_ = 0; b_ < NVB; ++b_) {
                    if (b_ + 1 < NVB) AT_VLOAD(b_ + 1, (b_ + 1) & 1);
                    __builtin_amdgcn_sched_barrier(0);
                    const int kk_ = b_ / NCB, c0_ = (b_ % NCB) * CBB;
                    __builtin_amdgcn_s_setprio(1);
#pragma unroll
                    for (int x_ = 0; x_ < CBB; ++x_)
#pragma unroll
                        for (int mp = 0; mp < NMAP; ++mp) o[mp][c0_ + x_] = __builtin_amdgcn_mfma_f32_16x16x32_bf16(vfr[b_ & 1][x_], pb[mp][kk_], o[mp][c0_ + x_], 0, 0, 0);
                    __builtin_amdgcn_s_setprio(0);
                    __builtin_amdgcn_sched_barrier(0);
                }
#undef AT_VLOAD
            }
        }
        if (!stage_first && kt + 1 < nkt) { AT_STORE(((kt + 1) & 1) * BUF_BYTES); if (kt + 2 < nkt) AT_LOAD(kt + 2); }
    }
#undef AT_LOAD
#undef AT_BAR
#undef AT_STORE
    if (MODE < 2) {
#pragma unroll
        for (int mp = 0; mp < NMAP; ++mp) l[mp] = xsum_rows(l[mp]);
    }
}
constexpr int S5_LDS_WAVE = 28160;
__device__ __forceinline__ void s5_unit(LAS unsigned char* lw, int b, int g, const float* lam_re, const float* lam_im, const float* log_step,
                                        const float* b_re, const float* b_im, const float* c_re, const float* c_im, const float* d_skip,
                                        const bf16_t* Z, bf16_t* Z5, int lane) {
    const int n = lane, r = lane & 15, g4 = lane >> 4;
    LAS float* U = (LAS float*)lw; LAS bf16_t* H = (LAS bf16_t*)(lw + 2048); LAS float* Xs = (LAS float*)(lw + 2048 + 8704); LAS f32x2* Fs = (LAS f32x2*)(lw + 2048 + 8704 + 16896);
    const float step = expf(log_step[g]); const float lr = fminf(lam_re[g * 64 + n], -1e-4f), li = lam_im[g * 64 + n];
    const float mag = expf(lr * step); float sn, cs; sincos_acc(li * step, sn, cs);
    const float are = mag * cs, aim = mag * sn;
    { const float den = lr * lr + li * li, nr = are - 1.0f, ni = aim; Fs[n] = (f32x2){(nr * lr + ni * li) / den, (ni * lr - nr * li) / den}; }
    WSYNC();
    bf16x8 Bf[8];
#pragma unroll
    for (int nb = 0; nb < 8; ++nb) {
        const int ns = (nb & 3) * 16 + r; const f32x2 f = Fs[ns];
        u32x4 wv = (u32x4){0u, 0u, 0u, 0u};
        if (g4 < 2) {
            const f32x4 br0 = *(const f32x4*)(b_re + (size_t)(g * 64 + ns) * 16 + g4 * 8), br1 = *(const f32x4*)(b_re + (size_t)(g * 64 + ns) * 16 + g4 * 8 + 4);
            const f32x4 bi0 = *(const f32x4*)(b_im + (size_t)(g * 64 + ns) * 16 + g4 * 8), bi1 = *(const f32x4*)(b_im + (size_t)(g * 64 + ns) * 16 + g4 * 8 + 4);
            f32x4 v0, v1;
            if (nb < 4) { v0 = br0 * f.x - bi0 * f.y; v1 = br1 * f.x - bi1 * f.y; } else { v0 = bi0 * f.x + br0 * f.y; v1 = bi1 * f.x + br1 * f.y; }
            wv.x = cvt_pk_bf16(v0[0], v0[1]); wv.y = cvt_pk_bf16(v0[2], v0[3]); wv.z = cvt_pk_bf16(v1[0], v1[1]); wv.w = cvt_pk_bf16(v1[2], v1[3]);
        }
        Bf[nb] = __builtin_bit_cast(bf16x8, wv);
    }
    bf16x8 Cf[4];
#pragma unroll
    for (int kk = 0; kk < 4; ++kk)
#pragma unroll
        for (int e = 0; e < 8; ++e) { const int k = (kk & 1) * 32 + g4 * 8 + e;
            const float v = (kk < 2) ? c_re[(size_t)(g * 16 + r) * 64 + k] : -c_im[(size_t)(g * 16 + r) * 64 + k];
            Cf[kk][e] = (short)f2bf(v); }
    const float dsk = d_skip[g * 16 + r];
    float hr = 0.f, hi = 0.f;
    const bf16_t* zb = Z + (size_t)b * SEQ * ZW + g * 16;
    bf16_t* ob = Z5 + (size_t)b * SEQ * 512 + g * 16;
    const int g4c = g4 < 2 ? g4 : 0;
    u32x4 vnext = *(const u32x4*)(zb + (size_t)(lane >> 1) * ZW + (lane & 1) * 8);
    u32x4 an0 = *(const u32x4*)(zb + (size_t)r * ZW + g4c * 8), an1 = *(const u32x4*)(zb + (size_t)(16 + r) * ZW + g4c * 8);
    for (int tc = 0; tc < SEQ / 32; ++tc) {
        const int t0 = tc * 32;
        u32x4 a0 = an0, a1 = an1; if (g4 >= 2) { a0 = (u32x4){0u, 0u, 0u, 0u}; a1 = a0; }
        { const int tk = lane >> 1, hf = lane & 1; const u32x4 v = vnext;
          if (tc + 1 < SEQ / 32) { vnext = *(const u32x4*)(zb + (size_t)(t0 + 32 + tk) * ZW + hf * 8);
              an0 = *(const u32x4*)(zb + (size_t)(t0 + 32 + r) * ZW + g4c * 8); an1 = *(const u32x4*)(zb + (size_t)(t0 + 48 + r) * ZW + g4c * 8); }
          f32x4 a, c2; a[0] = bflo(v.x); a[1] = bfhi(v.x); a[2] = bflo(v.y); a[3] = bfhi(v.y); c2[0] = bflo(v.z); c2[1] = bfhi(v.z); c2[2] = bflo(v.w); c2[3] = bfhi(v.w);
          *(LAS f32x4*)(U + tk * 16 + hf * 8) = a; *(LAS f32x4*)(U + tk * 16 + hf * 8 + 4) = c2; }
#pragma unroll
        for (int rb = 0; rb < 2; ++rb) { const bf16x8 af = __builtin_bit_cast(bf16x8, rb ? a1 : a0);
#pragma unroll
            for (int nb = 0; nb < 8; ++nb) { const f32x4 xa = __builtin_amdgcn_mfma_f32_16x16x32_bf16(af, Bf[nb], (f32x4){0.f, 0.f, 0.f, 0.f}, 0, 0, 0);
#pragma unroll
                for (int j = 0; j < 4; ++j) Xs[(rb * 16 + g4 * 4 + j) * 132 + nb * 16 + r] = xa[j]; } }
        WSYNC();
        {
            float xrv[32], xiv[32]; unsigned hp[32];
#pragma unroll
            for (int t = 0; t < 32; ++t) { xrv[t] = Xs[t * 132 + n]; xiv[t] = Xs[t * 132 + 64 + n]; }
            __builtin_amdgcn_sched_barrier(0);
#pragma unroll
            for (int t = 0; t < 32; ++t) { const float nhr = are * hr - aim * hi + xrv[t], nhi = are * hi + aim * hr + xiv[t]; hr = nhr; hi = nhi; hp[t] = cvt_pk_bf16(hr, hi); }
            __builtin_amdgcn_sched_barrier(0);
#pragma unroll
            for (int t = 0; t < 32; ++t) { H[t * 136 + n] = (bf16_t)(hp[t] & 0xffffu); H[t * 136 + 64 + n] = (bf16_t)(hp[t] >> 16); }
        }
        WSYNC();
        {
            bf16x8 hf[2][4]; float uu[2][4];
#pragma unroll
            for (int rb = 0; rb < 2; ++rb) {
#pragma unroll
                for (int kk = 0; kk < 4; ++kk) hf[rb][kk] = *(const LAS bf16x8*)(H + (rb * 16 + r) * 136 + kk * 32 + g4 * 8);
#pragma unroll
                for (int j = 0; j < 4; ++j) uu[rb][j] = U[(rb * 16 + g4 * 4 + j) * 16 + r]; }
            __builtin_amdgcn_sched_barrier(0);
#pragma unroll
            for (int rb = 0; rb < 2; ++rb) {
                f32x4 acc = __builtin_amdgcn_mfma_f32_16x16x32_bf16(hf[rb][0], Cf[0], (f32x4){0.f, 0.f, 0.f, 0.f}, 0, 0, 0);
#pragma unroll
                for (int kk = 1; kk < 4; ++kk) acc = __builtin_amdgcn_mfma_f32_16x16x32_bf16(hf[rb][kk], Cf[kk], acc, 0, 0, 0);
#pragma unroll
                for (int j = 0; j < 4; ++j) { const int t = rb * 16 + g4 * 4 + j; const float y = acc[j] + dsk * uu[rb][j];
                    ob[(size_t)(t0 + t) * 512 + r] = f2bf(gelu_tanh(y)); }
            }
        }
        WSYNC();
    }
}

#define RLX_AGENT __ATOMIC_RELAXED, __HIP_MEMORY_SCOPE_AGENT
#define XB_TMO      128
#define XB_XCNT(j)  (256  + 64 * (j))
#define XB_XSUB(j)  (1280 + 64 * (j))
#define XB_XGEN(j)  (2304 + 64 * (j))
#define XB_TOP      3328
#define XB_TOPGEN   3392
#define XCD_BAR_WORDS 3456
#define XB_SPIN_CAP (1u << 18)

__device__ __forceinline__ unsigned xb_ld(unsigned* p)              { return __hip_atomic_load(p, __ATOMIC_RELAXED, __HIP_MEMORY_SCOPE_AGENT); }
__device__ __forceinline__ unsigned xb_add(unsigned* p, unsigned v) { return __hip_atomic_fetch_add(p, v, __ATOMIC_RELAXED, __HIP_MEMORY_SCOPE_AGENT); }
__device__ __forceinline__ unsigned xb_xcc_id() { return (unsigned)__builtin_amdgcn_s_getreg((3 << 11) | 20) & 0xFu; }
#define XB_SPIN(cond, bar) do { unsigned _sp = 0; while (cond) { __builtin_amdgcn_s_sleep(1); \
    if ((++_sp & 255u) == 0u) { if (xb_ld(&(bar)[XB_TMO])) break; if (_sp > XB_SPIN_CAP) { atomicAdd(&(bar)[XB_TMO], 1u); break; } } } } while (0)

struct XcdBarrier {
    unsigned* bar; unsigned x;
    volatile LAS unsigned* st;
};

__device__ __forceinline__ XcdBarrier xcd_barrier_post(unsigned* bar, volatile LAS unsigned* st) {
    XcdBarrier b; b.bar = bar; b.x = xb_xcc_id(); b.st = st;
    if (threadIdx.x == 0) (void)xb_add(&bar[XB_XCNT(b.x)], 1u);
    return b;
}
__device__ __forceinline__ void xcd_barrier_complete(unsigned* bar, unsigned x, unsigned& nloc, unsigned& nx) {
    const unsigned G = gridDim.x * gridDim.y * gridDim.z;
    unsigned sum, cnt, mine, sp = 0u;
    for (;;) {
        sum = 0u; cnt = 0u; mine = 0u;
#pragma unroll
        for (unsigned j = 0; j < 16; ++j) { const unsigned c = xb_ld(&bar[XB_XCNT(j)]); sum += c; cnt += (c > 0u) ? 1u : 0u; mine = (j == x) ? c : mine; }
        if (sum == G) break;
        __builtin_amdgcn_s_sleep(1);
        if ((++sp & 255u) == 0u) { if (xb_ld(&bar[XB_TMO])) break; if (sp > XB_SPIN_CAP) { atomicAdd(&bar[XB_TMO], 1u); break; } }
    }
    nloc = mine > 0u ? mine : 1u; nx = cnt > 0u ? cnt : 1u;
}

__device__ __forceinline__ void xcd_barrier(const XcdBarrier& b) {
    asm volatile("s_waitcnt vmcnt(0)" ::: "memory");
    __syncthreads();
    if (threadIdx.x == 0) {
        unsigned* bar = b.bar;
        __builtin_amdgcn_s_waitcnt(0);
        unsigned nloc = b.st[0], nx = b.st[1];
        if (nloc == 0u) { xcd_barrier_complete(bar, b.x, nloc, nx); b.st[0] = nloc; b.st[1] = nx; }
        const unsigned old = xb_add(&bar[XB_XSUB(b.x)], 1u);
        const unsigned gen = old / nloc;
        if (old + 1u == (gen + 1u) * nloc) {
            __builtin_amdgcn_fence(__ATOMIC_RELEASE, "agent");
            asm volatile("s_waitcnt vmcnt(0)" ::: "memory");
            const unsigned og = xb_add(&bar[XB_TOP], 1u);
            const unsigned tg = og / nx;
            if (og + 1u == (tg + 1u) * nx) xb_add(&bar[XB_TOPGEN], 1u);
            else XB_SPIN(xb_ld(&bar[XB_TOPGEN]) == tg, bar);
            __builtin_amdgcn_fence(__ATOMIC_ACQUIRE, "agent");
            xb_add(&bar[XB_XGEN(b.x)], 1u);
            asm volatile("s_waitcnt vmcnt(0)" ::: "memory");
        } else {
            XB_SPIN(xb_ld(&bar[XB_XGEN(b.x)]) == gen, bar);
            __builtin_amdgcn_fence(__ATOMIC_ACQUIRE, "agent");
            asm volatile("s_waitcnt vmcnt(0)" ::: "memory");
        }
    }
    __syncthreads();
}

__device__ __forceinline__ void xcd_barrier_fast(const XcdBarrier& b) {
    asm volatile("s_waitcnt vmcnt(0)" ::: "memory");
    __syncthreads();
    if (threadIdx.x == 0) {
        unsigned* bar = b.bar;
        __builtin_amdgcn_s_waitcnt(0);
        unsigned nloc = b.st[0], nx = b.st[1];
        const unsigned old = xb_add(&bar[XB_XSUB(b.x)], 1u);
        const unsigned gen = old / nloc;
        if (old + 1u == (gen + 1u) * nloc) {
            __builtin_amdgcn_fence(__ATOMIC_RELEASE, "agent");
            asm volatile("s_waitcnt vmcnt(0)" ::: "memory");
            const unsigned og = xb_add(&bar[XB_TOP], 1u);
            const unsigned tg = og / nx;
            if (og + 1u == (tg + 1u) * nx) xb_add(&bar[XB_TOPGEN], 1u);
            else XB_SPIN(xb_ld(&bar[XB_TOPGEN]) == tg, bar);
            __builtin_amdgcn_fence(__ATOMIC_ACQUIRE, "agent");
            xb_add(&bar[XB_XGEN(b.x)], 1u);
            asm volatile("s_waitcnt vmcnt(0)" ::: "memory");
        } else {
            XB_SPIN(xb_ld(&bar[XB_XGEN(b.x)]) == gen, bar);
            __builtin_amdgcn_fence(__ATOMIC_ACQUIRE, "agent");
            asm volatile("s_waitcnt vmcnt(0)" ::: "memory");
        }
    }
    __syncthreads();
}

__global__ void __launch_bounds__(512, 2) mega_fwd(Params P) {
    extern __shared__ __attribute__((aligned(16))) unsigned char lds_raw[];
    cg::grid_group grid = cg::this_grid();
    LAS unsigned char* lds = (LAS unsigned char*)lds_raw;
    volatile LAS unsigned* bst = (volatile LAS unsigned*)(lds + 156144);
    if (threadIdx.x < 2) bst[threadIdx.x] = 0u;
    __syncthreads();
    (void)xcd_barrier_post((unsigned*)P.ws, bst);
#define GRID_BAR() do { XcdBarrier b_; b_.bar = (unsigned*)P.ws; b_.x = xb_xcc_id(); b_.st = (volatile LAS unsigned*)(lds + 156144); xcd_barrier_fast(b_); } while (0)
#define PHASE_IDS() int tid_ = threadIdx.x; asm volatile("" : "+v"(tid_)); const int tid = tid_, lane = tid & 63, wave = __builtin_amdgcn_readfirstlane(tid >> 6); \
    int G_ = gridDim.x, blk_ = blockIdx.x; asm volatile("" : "+s"(G_), "+s"(blk_)); const int G = G_, blk = blk_, gw = blk * 8 + wave, NGW = G * 8; \
    const size_t gtid = (size_t)blk * 512 + tid, GT = (size_t)G * 512; (void)lane; (void)gw; (void)NGW; (void)gtid; (void)GT; \
    unsigned char* ws = P.ws; float* X = P.out; asm volatile("" : "+s"(ws), "+s"(X)); \
    f32x2* ROPE_DA = (f32x2*)(ws + WS_ROPE_DA); f32x2* ROPE_RET = (f32x2*)(ws + WS_ROPE_RET); \
    bf16_t* W = (bf16_t*)(ws + WS_W); bf16_t* MEMB = (bf16_t*)(ws + WS_MEMB); bf16_t* XB = (bf16_t*)(ws + WS_XB); \
    bf16_t* BIG = (bf16_t*)(ws + WS_BIG); bf16_t* CAT = (bf16_t*)(ws + WS_CAT); \
    unsigned* AB = (unsigned*)(ws + WS_AUX); bf16_t* XC = (bf16_t*)(ws + WS_AUX2); bf16_t* Z5 = (bf16_t*)(ws + WS_AUX); bf16_t* KV = (bf16_t*)(ws + WS_AUX); \
    (void)X; (void)ROPE_DA; (void)ROPE_RET; (void)W; (void)MEMB; (void)XB; (void)BIG; (void)CAT; (void)AB; (void)XC; (void)Z5; (void)KV; \
    int l = lcur; asm volatile("" : "+s"(l)); const bf16_t* Wl = W + (size_t)l * LAYER_W; const int hl = l >> 1; bf16_t* Z = BIG; (void)Wl; (void)hl; (void)Z;
#define LN_CTX() const int kcur = l * 4 + si_; float* Scur = (float*)(ws + WS_STATS) + (size_t)(kcur & 1) * 524288; float* Snxt = (float*)(ws + WS_STATS) + (size_t)((kcur + 1) & 1) * 524288; \
    const float* cvk = (const float*)(ws + WS_CVEC) + (size_t)kcur * CVEC_STRIDE; (void)Scur; (void)Snxt; (void)cvk;
#define ZERO_SNXT()
    int lcur = 0;

    {
        PHASE_IDS();
        LAS float* scr = (LAS float*)(lds + wave * 16384);
        int base_item = 0;
        for (int l = 0; l < 4; ++l) {
            bf16_t* Wl = W + (size_t)l * LAYER_W;
            for (int s = 0; s < 2; ++s) {
                const size_t wi = (size_t)(l * 2 + s) * 1024 * 2816;
                const int kq = l * 4 + (s ? 3 : 0);
                const float* gs1 = kq ? P.in[2] + (size_t)(kq - 1) * 1024 : nullptr;
                transpose_mat(P.in[4] + wi, 1024, 2816, Wl + OFF_W1 + s * SZ_W1, 1, 0, scr, gw, NGW, lane, base_item, gs1);
                transpose_mat(P.in[5] + wi, 1024, 2816, Wl + OFF_W1 + s * SZ_W1, 1, 128, scr, gw, NGW, lane, base_item, gs1);
                transpose_mat(P.in[6] + wi, 2816, 1024, Wl + OFF_W2 + s * SZ_W2, 0, 0, scr, gw, NGW, lane, base_item);
            }
            transpose_mat(P.in[7] + (size_t)l * 1048576, 1024, 1024, Wl + OFF_WQ, 0, 0, scr, gw, NGW, lane, base_item, P.in[2] + (size_t)(l * 4 + 1) * 1024);
            transpose_mat(P.in[8] + (size_t)l * 2097152, 1024, 2048, Wl + OFF_WKV, 0, 0, scr, gw, NGW, lane, base_item);
            transpose_mat(P.in[9] + (size_t)l * 1048576, 1024, 1024, Wl + OFF_WO, 0, 0, scr, gw, NGW, lane, base_item);
            const int h = l >> 1;
            if (l & 1) transpose_mat(P.in[19] + (size_t)h * 2097152, 1024, 2048, Wl + OFF_WIN, 0, 0, scr, gw, NGW, lane, base_item, P.in[2] + (size_t)(l * 4) * 1024);
            else transpose_mat(P.in[10] + (size_t)h * 2621440, 1024, 2560, Wl + OFF_WIN, 0, 0, scr, gw, NGW, lane, base_item, P.in[2] + (size_t)(l * 4) * 1024);
            transpose_mat(((l & 1) ? P.in[20] : P.in[11]) + (size_t)h * 1048576, 1024, 1024, Wl + OFF_WOUT, 0, 0, scr, gw, NGW, lane, base_item);
            if (l & 1) transpose_mat(P.in[29] + (size_t)h * 262144, 512, 512, Wl + OFF_WEX, 0, 0, scr, gw, NGW, lane, base_item);
            else {
                const float* gwt = P.in[16] + (size_t)h * 2 * 8 * 64 * 64;
                bf16_t* dst = Wl + OFF_WEX;
                for (size_t i = gtid; i < (size_t)1024 * 512; i += GT) { const int row = (int)(i >> 9), k = (int)(i & 511);
                    const int pn = row >> 8, gsel = (row >> 7) & 1, ch = pn * 128 + (row & 127);
                    float v = 0.f; if ((k >> 6) == (ch >> 6)) v = gwt[(((size_t)gsel * 8 + (ch >> 6)) * 64 + (k & 63)) * 64 + (ch & 63)];
                    dst[i] = f2bf(v); }
            }
        }
        for (size_t idx = gtid; idx < (size_t)4 * 14848; idx += GT) {
            const int l = (int)(idx / 14848); int rem = (int)(idx % 14848); const int h = l >> 1;
            int k; const float* Wp; int N, n, drow;
            if (rem < 5632) { k = l * 4; const int half = rem / 2816; n = rem % 2816; Wp = (half ? P.in[5] : P.in[4]) + (size_t)(l * 2) * 1024 * 2816; N = 2816; drow = (n >> 7) * 256 + half * 128 + (n & 127); }
            else if (rem < 8192) { rem -= 5632; k = l * 4 + 1; n = rem; N = (l & 1) ? 2048 : 2560; Wp = (l & 1) ? P.in[19] + (size_t)h * 2097152 : P.in[10] + (size_t)h * 2621440; drow = n; }
            else if (rem < 9216) { rem -= 8192; k = l * 4 + 2; n = rem; N = 1024; Wp = P.in[7] + (size_t)l * 1048576; drow = n; }
            else { rem -= 9216; k = l * 4 + 3; const int half = rem / 2816; n = rem % 2816; Wp = (half ? P.in[5] : P.in[4]) + (size_t)(l * 2 + 1) * 1024 * 2816; N = 2816; drow = (n >> 7) * 256 + half * 128 + (n & 127); }
            if (n < N) {
                float s1 = 0.f, s2 = 0.f;
                if (k == 0) {
#pragma unroll 16
                    for (int kk = 0; kk < 1024; ++kk) s1 += Wp[(size_t)kk * N + n];
                } else {
                    const float* gq = P.in[2] + (size_t)(k - 1) * 1024; const float* bq = P.in[3] + (size_t)(k - 1) * 1024;
#pragma unroll 16
                    for (int kk = 0; kk < 1024; ++kk) { const float wv = Wp[(size_t)kk * N + n]; s1 += gq[kk] * wv; s2 += bq[kk] * wv; }
                }
                float* cv = (float*)(ws + WS_CVEC) + (size_t)k * CVEC_STRIDE; cv[drow] = s1; cv[5632 + drow] = s2;
            }
        }
        for (size_t i = gtid; i < 1024; i += GT) { ((float*)(ws + WS_ONES))[i] = 1.0f; ((float*)(ws + WS_ZEROS))[i] = 0.0f; }
        for (size_t i = gtid; i < (size_t)T_TOK * 4; i += GT) { ((f32x2*)(ws + WS_STATS))[i] = (f32x2){0.f, (i & 3) ? 0.f : 1024.0f * (1.0f - 1e-5f)}; }
        for (size_t i = gtid; i < 1024; i += GT) { const float L = P.in[18][i]; ((float*)(ws + WS_SPL))[i] = -8.0f * (fmaxf(-L, 0.f) + log1pf(expf(-fabsf(L)))); }
        for (size_t i0 = gtid; i0 < (size_t)MEMT * DM / 4; i0 += GT * 4) {
            f32x4 vv[4];
#pragma unroll
            for (int q = 0; q < 4; ++q) { const size_t i = i0 + (size_t)q * GT; vv[q] = (i < (size_t)MEMT * DM / 4) ? ((const f32x4*)P.in[1])[i] : (f32x4){0.f, 0.f, 0.f, 0.f}; }
#pragma unroll
            for (int q = 0; q < 4; ++q) { const size_t i = i0 + (size_t)q * GT; if (i < (size_t)MEMT * DM / 4) { const f32x4 v = vv[q];
                ((unsigned long long*)MEMB)[i] = (unsigned long long)cvt_pk_bf16(v[0], v[1]) | ((unsigned long long)cvt_pk_bf16(v[2], v[3]) << 32); } }
        }
        for (size_t i0 = gtid; i0 < (size_t)T_TOK * DM / 4; i0 += GT * 8) {
            f32x4 vv[8];
#pragma unroll
            for (int q = 0; q < 8; ++q) { const size_t i = i0 + (size_t)q * GT; vv[q] = (i < (size_t)T_TOK * DM / 4) ? ((const f32x4*)P.in[0])[i] : (f32x4){0.f, 0.f, 0.f, 0.f}; }
#pragma unroll
            for (int q = 0; q < 8; ++q) { const size_t i = i0 + (size_t)q * GT; if (i < (size_t)T_TOK * DM / 4) { const f32x4 v = vv[q];
                const unsigned h0 = cvt_pk_bf16(v[0], v[1]), h1 = cvt_pk_bf16(v[2], v[3]);
                const unsigned l0 = cvt_pk_bf16(v[0] - bflo(h0), v[1] - bfhi(h0)), l1 = cvt_pk_bf16(v[2] - bflo(h1), v[3] - bfhi(h1));
                ((unsigned long long*)XB)[i] = (unsigned long long)h0 | ((unsigned long long)h1 << 32);
                const size_t row = i >> 8, c4 = i & 255;
                ((unsigned long long*)X)[row * 512 + 256 + c4] = (unsigned long long)l0 | ((unsigned long long)l1 << 32); } }
        }
        for (size_t i = gtid; i < (size_t)SEQ * 40; i += GT) { const int pos = (int)(i / 40), e = (int)(i % 40);
            float inv; if (e < 8) inv = (float)exp2(-((double)e * 2.0 / 16.0) * 18.931568569324174);
            else inv = (float)exp2(-((double)(e - 8) * 2.0 / 64.0) * 13.287712379549449);
            const float ang = (float)pos * inv; float s, c; sincos_acc(ang, s, c);
            if (e < 8) ROPE_DA[pos * 8 + e] = (f32x2){c, s}; else ROPE_RET[pos * 32 + (e - 8)] = (f32x2){c, s}; }
    }
    __syncthreads();
    grid.sync();
    { XcdBarrier b_; b_.bar = (unsigned*)P.ws; b_.x = xb_xcc_id(); b_.st = (volatile LAS unsigned*)(lds + 156144); xcd_barrier(b_); }

    for (lcur = 0; lcur < 4; ++lcur) {
        const bool odd = (lcur & 1) != 0;
        for (int si = 0; si < 4; ++si) {
            int asel; size_t boff; int Kres; float sres;
            if (si == 0 || si == 3) {
                const int s = (si == 0) ? 0 : 1;
                { PHASE_IDS(); int si_ = si; asm volatile("" : "+s"(si_)); LN_CTX(); ZERO_SNXT(); pg8::Gemm g{XB, Wl + OFF_W1 + s * SZ_W1, T_TOK, 5632, 1024}; pg8::StaticOrder S; S.init(T_TOK, 5632, G, blk);
                  { LAS unsigned* CV = (LAS unsigned*)(lds + 131072); for (int i = tid; i < 5632; i += 512) CV[i] = (cvt_pk_bf16(cvk[i], 0.f) & 0xffffu) | (cvt_pk_bf16(cvk[5632 + i], 0.f) << 16);
                    if (tid < 2) ((volatile LAS int*)(lds + 155648))[tid] = -1; __syncthreads(); }
                  pg8::EpiSwiglu E{BIG, DFF, pg8::LnFix{Scur, cvk, cvk + 5632}}; pg8::gemm_phase<pg8::EpiSwiglu, pg8::StaticOrder, true, true>(lds, g, S, E); }
                GRID_BAR();
                asel = 0; boff = OFF_W2 + s * SZ_W2; Kres = DFF; sres = 0.5f;
            } else if (si == 1) {
                { PHASE_IDS(); int si_ = si; asm volatile("" : "+s"(si_)); LN_CTX(); ZERO_SNXT(); const int nin = odd ? 2048 : 2560; pg8::Gemm g{XB, Wl + OFF_WIN, T_TOK, nin, 1024}; pg8::StaticOrder S; S.init(T_TOK, nin, G, blk);
                  { LAS unsigned* CV = (LAS unsigned*)(lds + 131072); for (int i = tid; i < nin; i += 512) CV[i] = (cvt_pk_bf16(cvk[i], 0.f) & 0xffffu) | (cvt_pk_bf16(cvk[5632 + i], 0.f) << 16);
                    if (tid < 2) ((volatile LAS int*)(lds + 155648))[tid] = -1; __syncthreads(); }
                  pg8::EpiStore E{BIG, ZW, pg8::LnFix{Scur, cvk, cvk + 5632}}; pg8::gemm_phase<pg8::EpiStore, pg8::StaticOrder, true, true>(lds, g, S, E); }
                GRID_BAR();
                if (!odd) {
                    { PHASE_IDS();
                    for (size_t idx0 = gtid; idx0 < (size_t)T_TOK * 16; idx0 += GT * 4) {
                        u32x4 av[4], bv4[4]; f32x4 tv[4][4];
#pragma unroll
                        for (int q = 0; q < 4; ++q) { const size_t idx = idx0 + (size_t)q * GT; const bool ok = idx < (size_t)T_TOK * 16; const size_t ix = ok ? idx : 0;
                            const int row = (int)(ix >> 4), sub = (int)(ix & 15), qk = sub >> 3, hm = sub & 7, pos = row & (SEQ - 1);
                            const bf16_t* p = Z + (size_t)row * ZW + qk * 512 + hm * 64; av[q] = *(const u32x4*)p; bv4[q] = *(const u32x4*)(p + 8);
#pragma unroll
                            for (int e = 0; e < 4; ++e) tv[q][e] = ((const f32x4*)(ROPE_DA + pos * 8))[e]; }
#pragma unroll
                        for (int q = 0; q < 4; ++q) { const size_t idx = idx0 + (size_t)q * GT; if (idx < (size_t)T_TOK * 16) {
                            const int row = (int)(idx >> 4), sub = (int)(idx & 15), qk = sub >> 3, hm = sub & 7;
                            bf16_t* p = Z + (size_t)row * ZW + qk * 512 + hm * 64; float o1[8], o2[8];
#pragma unroll
                            for (int e = 0; e < 8; ++e) { const unsigned wa = av[q][e >> 1], wb = bv4[q][e >> 1]; const float x1 = (e & 1) ? bfhi(wa) : bflo(wa), x2 = (e & 1) ? bfhi(wb) : bflo(wb);
                                const float cs_ = tv[q][e >> 1][(e & 1) * 2], sn_ = tv[q][e >> 1][(e & 1) * 2 + 1]; o1[e] = x1 * cs_ - x2 * sn_; o2[e] = x1 * sn_ + x2 * cs_; }
                            u32x4 wa, wb; wa.x = cvt_pk_bf16(o1[0], o1[1]); wa.y = cvt_pk_bf16(o1[2], o1[3]); wa.z = cvt_pk_bf16(o1[4], o1[5]); wa.w = cvt_pk_bf16(o1[6], o1[7]);
                            wb.x = cvt_pk_bf16(o2[0], o2[1]); wb.y = cvt_pk_bf16(o2[2], o2[3]); wb.z = cvt_pk_bf16(o2[4], o2[5]); wb.w = cvt_pk_bf16(o2[6], o2[7]);
                            *(u32x4*)p = wa; *(u32x4*)(p + 8) = wb; } }
                    }
                    { const float* cw = P.in[14] + (size_t)hl * 4 * 512; const float* cbs = P.in[15] + (size_t)hl * 512;
                      const int c0 = (int)(gtid & 63) * 8;
                      f32x4 wv[4][2], bb[2];
#pragma unroll
                      for (int j = 0; j < 4; ++j) { wv[j][0] = *(const f32x4*)(cw + j * 512 + c0); wv[j][1] = *(const f32x4*)(cw + j * 512 + c0 + 4); }
                      bb[0] = *(const f32x4*)(cbs + c0); bb[1] = *(const f32x4*)(cbs + c0 + 4);
                      for (size_t idx0 = gtid; idx0 < (size_t)T_TOK * 64; idx0 += GT * 4) {
                        u32x4 xv[4][4];
#pragma unroll
                        for (int q = 0; q < 4; ++q) { const size_t idx = idx0 + (size_t)q * GT; const bool ok = idx < (size_t)T_TOK * 64; const int row = ok ? (int)(idx >> 6) : 3, pos = row & (SEQ - 1);
#pragma unroll
                            for (int j = 0; j < 4; ++j) xv[q][j] = (pos - 3 + j >= 0) ? *(const u32x4*)(Z + (size_t)(row - 3 + j) * ZW + 2048 + c0) : (u32x4){0u, 0u, 0u, 0u}; }
#pragma unroll
                        for (int q = 0; q < 4; ++q) { const size_t idx = idx0 + (size_t)q * GT; if (idx < (size_t)T_TOK * 64) { const int row = (int)(idx >> 6);
                            f32x4 a0 = bb[0], a1 = bb[1];
#pragma unroll
                            for (int j = 0; j < 4; ++j) { const u32x4 v = xv[q][j]; f32x4 x0, x1; x0[0] = bflo(v.x); x0[1] = bfhi(v.x); x0[2] = bflo(v.y); x0[3] = bfhi(v.y); x1[0] = bflo(v.z); x1[1] = bfhi(v.z); x1[2] = bflo(v.w); x1[3] = bfhi(v.w);
                                a0 += wv[j][0] * x0; a1 += wv[j][1] * x1; }
                            u32x4 o; o.x = cvt_pk_bf16(a0[0], a0[1]); o.y = cvt_pk_bf16(a0[2], a0[3]); o.z = cvt_pk_bf16(a1[0], a1[1]); o.w = cvt_pk_bf16(a1[2], a1[3]);
                            *(u32x4*)(XC + (size_t)row * 512 + c0) = o; } }
                      } }
                    }
                    GRID_BAR();
                    { PHASE_IDS(); pg8::Gemm g{XC, Wl + OFF_WEX, T_TOK, 1024, 512}; pg8::StaticOrder S; S.init(T_TOK, 1024, G, blk);
                      pg8::EpiLru E{AB, XC, P.in[17] + (size_t)hl * 1024, (const float*)(ws + WS_SPL) + (size_t)hl * 512};
                      pg8::gemm_phase<pg8::EpiLru, pg8::StaticOrder, true, true>(lds, g, S, E); }
                    GRID_BAR();
                    { PHASE_IDS();
                        const float* lamp = P.in[12] + (size_t)hl * 256; const float* ng = P.in[13] + (size_t)hl * 128;
                        float d1 = lamp[lane] * lamp[64 + lane], d2 = lamp[128 + lane] * lamp[192 + lane]; d1 = wave_sum(d1); d2 = wave_sum(d2);
                        const float lam_init = 0.8f - 0.6f * expf(-0.3f * (float)l);
                        const float lmb = expf(d1) - expf(d2) + lam_init;
                        const int r = lane & 15, g4 = lane >> 4;
                        for (int u = blk; u < 2048; u += G) {
                            const int bh = u & 127, b = bh >> 2, h = bh & 3, qi_ = u >> 7, ii_ = qi_ >> 1, hb_ = qi_ & 1, qt = (ii_ & 1) ? (ii_ - 1 + hb_) : (15 - hb_ - ii_), q0 = qt * 128, nkt = (q0 + 128) / 64;
                            const size_t rb = (size_t)b * SEQ;
                            f32x4 o[2][8]; float ll[2];
                            attn_core3<64, 128, 1, 2, 64>(lds, Z + (rb + q0) * ZW + h * 128, ZW, Z + rb * ZW + 512 + h * 128, ZW, Z + rb * ZW + 1024 + h * 128, ZW, q0, nkt, 0.125f * LOG2E, 0.f, o, ll);
                            const float iv0 = 1.0f / ll[0], f1 = lmb / ll[1]; float ss = 0.f;
#pragma unroll
                            for (int cb = 0; cb < 8; ++cb)
#pragma unroll
                                for (int j = 0; j < 4; ++j) { const float v = o[0][cb][j] * iv0 - f1 * o[1][cb][j]; o[0][cb][j] = v; ss += v * v; }
                            ss = xsum_rows(ss);
                            const float rs = rsqrtf(ss * (1.0f / 128.0f) + LN_EPS) * (1.0f - lam_init);
                            const size_t row = rb + q0 + wave * 16 + r;
                            f32x4 ggv[8];
#pragma unroll
                            for (int cb = 0; cb < 8; ++cb) ggv[cb] = *(const f32x4*)(ng + cb * 16 + g4 * 4);
#pragma unroll
                            for (int cb = 0; cb < 8; ++cb) { const f32x4 gg = ggv[cb]; const f32x4 v = o[0][cb] * rs * gg;
                                u32x2 wv; wv.x = cvt_pk_bf16(v[0], v[1]); wv.y = cvt_pk_bf16(v[2], v[3]); *(u32x2*)(CAT + row * 1024 + h * 128 + cb * 16 + g4 * 4) = wv; }
                        }
                    }
                    { PHASE_IDS();
                        LAS float* sA = (LAS float*)lds; LAS float* sB = sA + 32 * 64;
                        for (int u = blk; u < 256; u += G) {
                            const int b = u >> 3, cgp = u & 7, jc = tid >> 4, q = tid & 15, ch0 = cgp * 64 + q * 4;
                            const size_t row0 = (size_t)b * SEQ + jc * 64;
                            const unsigned* ab = AB + row0 * 512 + ch0;
                            float h[4] = {0.f, 0.f, 0.f, 0.f}, sl[4] = {0.f, 0.f, 0.f, 0.f};
                            for (int t0 = 0; t0 < 64; t0 += 16) {
                                u32x4 wv[16];
#pragma unroll
                                for (int i = 0; i < 16; ++i) wv[i] = *(const u32x4*)(ab + (size_t)(t0 + i) * 512);
#pragma unroll
                                for (int i = 0; i < 16; ++i)
#pragma unroll
                                    for (int k = 0; k < 4; ++k) { const float la = bflo(wv[i][k]), bb = bfhi(wv[i][k]); h[k] = __builtin_amdgcn_exp2f(la) * h[k] + bb; sl[k] += la; }
                            }
                            __syncthreads();
                            *(LAS f32x4*)(sA + jc * 64 + q * 4) = (f32x4){sl[0], sl[1], sl[2], sl[3]}; *(LAS f32x4*)(sB + jc * 64 + q * 4) = (f32x4){h[0], h[1], h[2], h[3]};
                            __syncthreads();
                            float hin[4] = {0.f, 0.f, 0.f, 0.f};
#pragma unroll 8
                            for (int jj = 0; jj < 31; ++jj) { const f32x4 a4 = *(const LAS f32x4*)(sA + jj * 64 + q * 4), b4 = *(const LAS f32x4*)(sB + jj * 64 + q * 4); const bool on = jj < jc;
#pragma unroll
                                for (int k = 0; k < 4; ++k) { const float av = on ? __builtin_amdgcn_exp2f(a4[k]) : 1.0f, bv_ = on ? b4[k] : 0.0f; hin[k] = av * hin[k] + bv_; } }
#pragma unroll
                            for (int k = 0; k < 4; ++k) h[k] = hin[k];
                            const bf16_t* gp = Z + row0 * ZW + 1536 + ch0; bf16_t* op = CAT + row0 * 1024 + 512 + ch0;
                            for (int t0 = 0; t0 < 64; t0 += 16) {
                                u32x4 wv[16]; u32x2 gv2[16];
#pragma unroll
                                for (int i = 0; i < 16; ++i) { wv[i] = *(const u32x4*)(ab + (size_t)(t0 + i) * 512); gv2[i] = *(const u32x2*)(gp + (size_t)(t0 + i) * ZW); }
#pragma unroll
                                for (int i = 0; i < 16; ++i) { float o4[4];
#pragma unroll
                                    for (int k = 0; k < 4; ++k) { const float la = bflo(wv[i][k]), bb = bfhi(wv[i][k]); h[k] = __builtin_amdgcn_exp2f(la) * h[k] + bb;
                                        const unsigned gw = gv2[i][k >> 1]; const float gt = (k & 1) ? bfhi(gw) : bflo(gw); o4[k] = gelu_tanh(gt) * h[k]; }
                                    u32x2 ow; ow.x = cvt_pk_bf16(o4[0], o4[1]); ow.y = cvt_pk_bf16(o4[2], o4[3]); *(u32x2*)(op + (size_t)(t0 + i) * 1024) = ow; }
                            }
                        }
                    }
                    __syncthreads();
                    GRID_BAR();
                } else {
                    { PHASE_IDS();
                    for (size_t idx0 = gtid; idx0 < (size_t)T_TOK * 32; idx0 += GT * 4) {
                        u32x4 av[4], bv4[4]; f32x4 tv[4][4];
#pragma unroll
                        for (int q = 0; q < 4; ++q) { const size_t idx = idx0 + (size_t)q * GT; const bool ok = idx < (size_t)T_TOK * 32; const size_t ix = ok ? idx : 0;
                            const int row = (int)(ix >> 5), sub = (int)(ix & 31), qk = sub >> 4, h = (sub >> 2) & 3, c = sub & 3, pos = row & (SEQ - 1);
                            const bf16_t* p = Z + (size_t)row * ZW + 512 + qk * 256 + h * 64 + c * 8; av[q] = *(const u32x4*)p; bv4[q] = *(const u32x4*)(p + 32);
#pragma unroll
                            for (int e = 0; e < 4; ++e) tv[q][e] = ((const f32x4*)(ROPE_RET + pos * 32 + c * 8))[e]; }
#pragma unroll
                        for (int q = 0; q < 4; ++q) { const size_t idx = idx0 + (size_t)q * GT; if (idx < (size_t)T_TOK * 32) {
                            const int row = (int)(idx >> 5), sub = (int)(idx & 31), qk = sub >> 4, h = (sub >> 2) & 3, c = sub & 3;
                            bf16_t* p = Z + (size_t)row * ZW + 512 + qk * 256 + h * 64 + c * 8; const float ksc = qk ? 0.125f : 1.0f; float o1[8], o2[8];
#pragma unroll
                            for (int e = 0; e < 8; ++e) { const unsigned wa = av[q][e >> 1], wb = bv4[q][e >> 1]; const float x1 = (e & 1) ? bfhi(wa) : bflo(wa), x2 = (e & 1) ? bfhi(wb) : bflo(wb);
                                const float cs_ = tv[q][e >> 1][(e & 1) * 2], sn_ = tv[q][e >> 1][(e & 1) * 2 + 1]; o1[e] = (x1 * cs_ - x2 * sn_) * ksc; o2[e] = (x1 * sn_ + x2 * cs_) * ksc; }
                            u32x4 wa, wb; wa.x = cvt_pk_bf16(o1[0], o1[1]); wa.y = cvt_pk_bf16(o1[2], o1[3]); wa.z = cvt_pk_bf16(o1[4], o1[5]); wa.w = cvt_pk_bf16(o1[6], o1[7]);
                            wb.x = cvt_pk_bf16(o2[0], o2[1]); wb.y = cvt_pk_bf16(o2[2], o2[3]); wb.z = cvt_pk_bf16(o2[4], o2[5]); wb.w = cvt_pk_bf16(o2[6], o2[7]);
                            *(u32x4*)p = wa; *(u32x4*)(p + 32) = wb; } }
                    }
                    }
                    __syncthreads();
                    { PHASE_IDS();
                    if (wave < 4) {
                        for (int u = blk * 4 + wave; u < 1024; u += G * 4)
                            s5_unit(lds + wave * S5_LDS_WAVE, u >> 5, u & 31, P.in[21] + (size_t)hl * 2048, P.in[22] + (size_t)hl * 2048, P.in[23] + (size_t)hl * 32,
                                    P.in[24] + (size_t)hl * 32768, P.in[25] + (size_t)hl * 32768, P.in[26] + (size_t)hl * 32768, P.in[27] + (size_t)hl * 32768,
                                    P.in[28] + (size_t)hl * 512, Z, Z5, lane);
                    }
                    }
                    __syncthreads();
                    GRID_BAR();
                    { PHASE_IDS();
                        const float* rg = P.in[31] + (size_t)hl * 128;
                        const int r = lane & 15, g4 = lane >> 4;
                        for (int u = blk; u < 2048; u += G) {
                            const int bh = u & 127, b = bh >> 2, h = bh & 3, qi_ = u >> 7, ii_ = qi_ >> 1, hb_ = qi_ & 1, qt = (ii_ & 1) ? (ii_ - 1 + hb_) : (15 - hb_ - ii_), q0 = qt * 128, nkt = qt + 1;
                            const size_t rb = (size_t)b * SEQ;
                            const float l2g = log2f(1.0f - exp2f(-5.0f - (float)h));
                            f32x4 o[1][8]; float ll[1];
                            attn_core3<64, 128, 2, 1, 128>(lds, Z + (rb + q0) * ZW + 512 + h * 64, ZW, Z + rb * ZW + 768 + h * 64, ZW, Z + rb * ZW + 1024 + h * 128, ZW, q0, nkt, 1.0f, l2g, o, ll);
                            float sm = 0.f;
#pragma unroll
                            for (int cb = 0; cb < 8; ++cb) sm += (o[0][cb][0] + o[0][cb][1]) + (o[0][cb][2] + o[0][cb][3]);
                            sm = xsum_rows(sm);
                            const float mean = sm * (1.0f / 128.0f); float sq = 0.f;
#pragma unroll
                            for (int cb = 0; cb < 8; ++cb) { o[0][cb] = o[0][cb] - mean; sq += (o[0][cb][0] * o[0][cb][0] + o[0][cb][1] * o[0][cb][1]) + (o[0][cb][2] * o[0][cb][2] + o[0][cb][3] * o[0][cb][3]); }
                            sq = xsum_rows(sq);
                            const float rstd = rsqrtf(sq * (1.0f / 128.0f) + LN_EPS);
                            const size_t row = rb + q0 + wave * 16 + r;
                            f32x4 ggv[8]; u32x2 gwv[8];
#pragma unroll
                            for (int cb = 0; cb < 8; ++cb) { const int col = cb * 16 + g4 * 4; ggv[cb] = *(const f32x4*)(rg + col); gwv[cb] = *(const u32x2*)(Z + row * ZW + 1536 + h * 128 + col); }
#pragma unroll
                            for (int cb = 0; cb < 8; ++cb) { const int col = cb * 16 + g4 * 4; const f32x4 gg = ggv[cb];
                                const u32x2 gw = gwv[cb];
                                f32x4 gt; gt[0] = bflo(gw.x); gt[1] = bfhi(gw.x); gt[2] = bflo(gw.y); gt[3] = bfhi(gw.y);
                                f32x4 v;
#pragma unroll
                                for (int j = 0; j < 4; ++j) v[j] = silu_f(gt[j]) * o[0][cb][j] * rstd * gg[j];
                                u32x2 wv; wv.x = cvt_pk_bf16(v[0], v[1]); wv.y = cvt_pk_bf16(v[2], v[3]); *(u32x2*)(CAT + row * 1024 + 512 + h * 128 + col) = wv; }
                        }
                    }
                    __syncthreads();
                    { PHASE_IDS(); pg8::Gemm g{Z5, Wl + OFF_WEX, T_TOK, 512, 512}; pg8::StaticOrder S; S.init(T_TOK, 512, G, blk);
                      pg8::EpiGlu E{CAT, 1024, Z5, P.in[30] + (size_t)hl * 512};
                      pg8::gemm_phase<pg8::EpiGlu, pg8::StaticOrder, true, true>(lds, g, S, E); }
                    GRID_BAR();
                }
                asel = 1; boff = OFF_WOUT; Kres = 1024; sres = 1.0f;
            } else {
                { PHASE_IDS(); int si_ = si; asm volatile("" : "+s"(si_)); LN_CTX(); ZERO_SNXT(); pg8::Gemm g{XB, Wl + OFF_WQ, T_TOK, 1024, 1024}; pg8::StaticOrder S; S.init(T_TOK, 1024, G, blk);
                  { LAS unsigned* CV = (LAS unsigned*)(lds + 131072); for (int i = tid; i < 1024; i += 512) CV[i] = (cvt_pk_bf16(cvk[i], 0.f) & 0xffffu) | (cvt_pk_bf16(cvk[5632 + i], 0.f) << 16);
                    if (tid < 2) ((volatile LAS int*)(lds + 155648))[tid] = -1; __syncthreads(); }
                  pg8::EpiStore E{BIG, 1024, pg8::LnFix{Scur, cvk, cvk + 5632}}; pg8::gemm_phase<pg8::EpiStore, pg8::StaticOrder, true, true>(lds, g, S, E); }
                { PHASE_IDS(); pg8::Gemm g{MEMB, Wl + OFF_WKV, MEMT, 2048, 1024}; pg8::StaticOrder S; S.init(MEMT, 2048, G, blk);
                  pg8::EpiStore E{KV, 2048, pg8::LnFix{nullptr, nullptr, nullptr}}; pg8::gemm_phase<pg8::EpiStore, pg8::StaticOrder, true, true>(lds, g, S, E); }
                GRID_BAR();
                { PHASE_IDS();
                    const int r = lane & 15, g4 = lane >> 4;
                    for (int u = blk; u < 2048; u += G) {
                        const int bh = u & 127, b = bh >> 2, h = bh & 3, qt = u >> 7, q0 = qt * 128;
                        const size_t rb = (size_t)b * SEQ;
                        f32x4 o[1][16]; float ll[1];
                        attn_core3<256, 256, 0, 1, 64>(lds, BIG + (rb + q0) * 1024 + h * 256, 1024, KV + (size_t)b * 256 * 2048 + h * 256, 2048, KV + (size_t)b * 256 * 2048 + 1024 + h * 256, 2048, q0, 4, 0.0625f * LOG2E, 0.f, o, ll);
                        const float iv = 1.0f / ll[0]; const size_t row = rb + q0 + wave * 16 + r;
#pragma unroll
                        for (int cb = 0; cb < 16; ++cb) { const f32x4 v = o[0][cb] * iv; u32x2 wv; wv.x = cvt_pk_bf16(v[0], v[1]); wv.y = cvt_pk_bf16(v[2], v[3]);
                            *(u32x2*)(CAT + row * 1024 + h * 256 + cb * 16 + g4 * 4) = wv; }
                    }
                }
                __syncthreads();
                GRID_BAR();
                asel = 1; boff = OFF_WO; Kres = 1024; sres = 1.0f;
            }
            { PHASE_IDS(); int si_ = si; asm volatile("" : "+s"(si_)); LN_CTX(); pg8::Gemm g{asel ? CAT : BIG, Wl + boff, T_TOK, 1024, Kres}; pg8::StaticOrder S; S.init(T_TOK, 1024, G, blk);
              const float* gpv = kcur ? P.in[2] + (size_t)(kcur - 1) * 1024 : (const float*)(ws + WS_ONES); const float* bpv = kcur ? P.in[3] + (size_t)(kcur - 1) * 1024 : (const float*)(ws + WS_ZEROS);
              { LAS float* gl = (LAS float*)(lds + 147456); for (int i = tid; i < 1024; i += 512) { gl[i] = gpv[i]; gl[1024 + i] = bpv[i]; } __syncthreads(); }
              pg8::EpiResid E{X, XB, Scur, Snxt, gpv, bpv, DN_ALPHA, sres}; pg8::gemm_phase<pg8::EpiResid, pg8::StaticOrder, true, true>(lds, g, S, E); }
            GRID_BAR();
            if (lcur == 3 && si == 3) { PHASE_IDS();
                const float* gp = P.in[2] + (size_t)15 * 1024; const float* bp = P.in[3] + (size_t)15 * 1024;
                f32x4 gv[4], bv[4];
#pragma unroll
                for (int j = 0; j < 4; ++j) { gv[j] = ((const f32x4*)gp)[lane + 64 * j]; bv[j] = ((const f32x4*)bp)[lane + 64 * j]; }
                for (int mrow0 = gw; mrow0 < T_TOK; mrow0 += 2 * NGW) {
                    f32x4 v[2][4];
#pragma unroll
                    for (int q = 0; q < 2; ++q) { const int mrow = (mrow0 + q * NGW < T_TOK) ? mrow0 + q * NGW : mrow0;
#pragma unroll
                        for (int j = 0; j < 4; ++j) { const unsigned long long hw = ((const unsigned long long*)(XB + (size_t)mrow * 1024))[lane + 64 * j], lw = ((const unsigned long long*)(X + (size_t)mrow * 1024))[256 + lane + 64 * j];
                            const unsigned h0 = (unsigned)hw, h1 = (unsigned)(hw >> 32), l0 = (unsigned)lw, l1 = (unsigned)(lw >> 32);
                            v[q][j][0] = bflo(h0) + bflo(l0); v[q][j][1] = bfhi(h0) + bfhi(l0); v[q][j][2] = bflo(h1) + bflo(l1); v[q][j][3] = bfhi(h1) + bfhi(l1); } }
#pragma unroll
                    for (int q = 0; q < 2; ++q) { const int mrow = mrow0 + q * NGW; if (mrow < T_TOK) {
                        f32x4* xr = (f32x4*)(X + (size_t)mrow * 1024) + lane; float s = 0.f;
#pragma unroll
                        for (int j = 0; j < 4; ++j) s += (v[q][j][0] + v[q][j][1]) + (v[q][j][2] + v[q][j][3]);
                        const float mean = wave_sum(s) * (1.0f / 1024.0f); float s2 = 0.f;
#pragma unroll
                        for (int j = 0; j < 4; ++j) { v[q][j] = v[q][j] - mean; s2 += (v[q][j][0] * v[q][j][0] + v[q][j][1] * v[q][j][1]) + (v[q][j][2] * v[q][j][2] + v[q][j][3] * v[q][j][3]); }
                        const float rstd = rsqrtf(wave_sum(s2) * (1.0f / 1024.0f) + LN_EPS);
#pragma unroll
                        for (int j = 0; j < 4; ++j) { const f32x4 y = v[q][j] * rstd * gv[j] + bv[j]; xr[64 * j] = y; } } }
                }
            }
        }
    }
}

extern "C" void kernel_launch(void* const* d_in, const int* in_sizes, int n_in, void* d_out, int out_size, void* d_ws, size_t ws_size, hipStream_t stream) {
    static int grid_blocks = 0;
    if (grid_blocks == 0) {
        if (n_in != 32 || out_size != T_TOK * DM || ws_size < WS_END) { fprintf(stderr, "kernel_launch: unexpected shapes (n_in %d out %d ws %zu)\n", n_in, out_size, ws_size); grid_blocks = -1; return; }
        int dev = 0, cus = 0, per_cu = 0;
        hipGetDevice(&dev); hipDeviceGetAttribute(&cus, hipDeviceAttributeMultiprocessorCount, dev);
        if (hipFuncSetAttribute((const void*)mega_fwd, hipFuncAttributeMaxDynamicSharedMemorySize, LDS_BYTES) != hipSuccess) { fprintf(stderr, "kernel_launch: hipFuncSetAttribute failed\n"); }
        if (hipOccupancyMaxActiveBlocksPerMultiprocessor(&per_cu, (const void*)mega_fwd, 512, LDS_BYTES) != hipSuccess || per_cu < 1) { fprintf(stderr, "kernel_launch: occupancy query says %d\n", per_cu); per_cu = 1; }
        (void)hipGetLastError();
        grid_blocks = cus * 1;
        fprintf(stderr, "kernel_launch: cus %d per_cu %d grid %d\n", cus, per_cu, grid_blocks);
    }
    if (grid_blocks < 0) return;
    Params p{};
    for (int i = 0; i < 32; ++i) p.in[i] = (const float*)d_in[i];
    p.out = (float*)d_out; p.ws = (unsigned char*)d_ws;
    if (hipMemsetAsync(d_ws, 0, 16384, stream) != hipSuccess) { fprintf(stderr, "kernel_launch: memset failed\n"); return; }
    void* args[] = {&p};
    hipError_t e = hipLaunchCooperativeKernel((const void*)mega_fwd, dim3(grid_blocks), dim3(512), args, LDS_BYTES, stream);
    if (e != hipSuccess) fprintf(stderr, "cooperative launch failed: %s (grid %d)\n", hipGetErrorString(e), grid_blocks);
}
```

```cpp
#include <hip/hip_runtime.h>
#include <hip/hip_cooperative_groups.h>
#include <cstdio>
#include <cstdint>
#include <type_traits>
namespace cg = cooperative_groups;
__device__ __forceinline__ float xsum16(float v) { auto rr = __builtin_amdgcn_permlane16_swap(__float_as_uint(v), __float_as_uint(v), false, false); return __uint_as_float(rr[0]) + __uint_as_float(rr[1]); }
__device__ __forceinline__ float xsum32(float v) { auto rr = __builtin_amdgcn_permlane32_swap(__float_as_uint(v), __float_as_uint(v), false, false); return __uint_as_float(rr[0]) + __uint_as_float(rr[1]); }
__device__ __forceinline__ float xmax16(float v) { auto rr = __builtin_amdgcn_permlane16_swap(__float_as_uint(v), __float_as_uint(v), false, false); return fmaxf(__uint_as_float(rr[0]), __uint_as_float(rr[1])); }
__device__ __forceinline__ float xmax32(float v) { auto rr = __builtin_amdgcn_permlane32_swap(__float_as_uint(v), __float_as_uint(v), false, false); return fmaxf(__uint_as_float(rr[0]), __uint_as_float(rr[1])); }
__device__ __forceinline__ float xsum_rows(float v) { return xsum32(xsum16(v)); }
__device__ __forceinline__ float xmax_rows(float v) { return xmax32(xmax16(v)); }
namespace pg8 {
#define PG8_LAS __attribute__((address_space(3)))
typedef unsigned short bf16_t;
typedef short bf16x8 __attribute__((ext_vector_type(8)));
typedef float f32x4 __attribute__((ext_vector_type(4)));
typedef unsigned u32x4 __attribute__((ext_vector_type(4)));
constexpr int BM = 256, BK = 64, HALF = 128, HTB = HALF * BK * 2  , STAGE_BYTES = 8 * HTB, NXCD = 8, WGM = 8;

__host__ __device__ __forceinline__ int lds_byte(int r, int c) { const int st = (r >> 4) * 2 + (c >> 5), rr = r & 15, cc = c & 31, ob = rr * 64 + cc * 2; return st * 1024 + (ob ^ (((ob >> 9) & 1) << 5)); }
__host__ __device__ __forceinline__ void stage_rc(int b, int& R, int& C) { const int st = b / 1024, sb = b % 1024, swz = sb ^ (((sb >> 9) & 1) << 5); R = (st >> 1) * 16 + swz / 64; C = (st & 1) * 32 + (swz % 64) / 2; }
__host__ __device__ __forceinline__ int perm32(int rho) { const int n = rho >> 4, i = rho & 15; return 8 * (i >> 2) + 4 * n + (i & 3); }

struct Unit { int pm, pn; };
struct Gemm { const bf16_t* A; const bf16_t* Bt; int M, N, K; };

struct StaticOrder {
    int nM, nN, nwg, G, c;
    __host__ __device__ void init(int M, int N, int G_, int c_) { nM = M / BM; nN = N / BM; nwg = nM * nN; G = G_; c = c_; }
    __host__ __device__ bool next(int i, Unit& u) const {
        const long L = (long)i * G + c; if (L >= nwg) return false;
        int wgid = (int)L; { const int q = nwg / NXCD, r = nwg % NXCD, xcd = wgid % NXCD, off = wgid / NXCD; wgid = (xcd < r ? xcd * (q + 1) : r * (q + 1) + (xcd - r) * q) + off; }
        const int nig = WGM * nN, gid = wgid / nig, fm = gid * WGM, gsz = (nM - fm) < WGM ? (nM - fm) : WGM;
        u.pm = fm + ((wgid % nig) % gsz); u.pn = (wgid % nig) / gsz; return true;
    }
    __device__ __forceinline__ void a_ready(const Unit&) const {}
    __device__ __forceinline__ void done(const Unit&) const {}
};

__device__ __forceinline__ unsigned cvt_pk_bf16(float lo, float hi) { unsigned r; asm volatile("v_cvt_pk_bf16_f32 %0, %1, %2" : "=v"(r) : "v"(lo), "v"(hi)); return r; }
typedef float f32x2 __attribute__((ext_vector_type(2)));
__device__ __forceinline__ float fast_sigmoid(float x) { return __builtin_amdgcn_rcpf(1.0f + __expf(-x)); }

struct LnFix { const float* st; const float* c1; const float* c2; };
__device__ __forceinline__ void ln_row(const float* st, int row, int fq, float& rs, float& ms) {
    f32x2 v = *(const f32x2*)(st + (unsigned)(8 * row + 2 * fq));
    v.x = xsum_rows(v.x); v.y = xsum_rows(v.y);
    const float mean = v.x * (1.0f / 1024.0f); const float var = v.y * (1.0f / 1024.0f) - mean * mean;
    rs = __builtin_amdgcn_rsqf(var + 1e-5f); ms = rs * mean;
}
struct EpiSwiglu {
    static constexpr bool PERM = true, AFTER_DRAIN = false;
    bf16_t* O; int ldo; LnFix ln;
    __device__ __forceinline__ void operator()(const f32x4 (&acc)[2][2][4][2], const Unit& u, int wr, int wc, int fr, int fq, PG8_LAS unsigned char* ldsb) const {
        const int row0 = u.pm * BM + wr * 64 + fr; const int col0 = u.pn * HALF + wc * 32 + 8 * fq;
        const int brow = u.pn * BM + wc * 32 + 8 * fq;
        const PG8_LAS unsigned* CV = (const PG8_LAS unsigned*)(ldsb + 131072);
        PG8_LAS f32x2* ST = (PG8_LAS f32x2*)(ldsb + 153600);
        volatile PG8_LAS int* TAG = (volatile PG8_LAS int*)(ldsb + 155648);
        float rsv[2][4], msv[2][4];
        if (TAG[wr] != u.pm) {
#pragma unroll
            for (int ai = 0; ai < 2; ++ai)
#pragma unroll
                for (int m = 0; m < 4; ++m) { ln_row(ln.st, row0 + ai * HALF + m * 16, fq, rsv[ai][m], msv[ai][m]);
                    f32x2 pr; pr.x = rsv[ai][m]; pr.y = msv[ai][m]; ST[ai * HALF + wr * 64 + m * 16 + fr] = pr; }
            asm volatile("s_waitcnt lgkmcnt(0)" ::: "memory");
            TAG[wr] = u.pm;
        } else {
#pragma unroll
            for (int ai = 0; ai < 2; ++ai)
#pragma unroll
                for (int m = 0; m < 4; ++m) { const f32x2 pr = ST[ai * HALF + wr * 64 + m * 16 + fr]; rsv[ai][m] = pr.x; msv[ai][m] = pr.y; }
        }
        float c1g[8], c2g[8], c1u[8], c2u[8];
        { const u32x4 g0 = *(const PG8_LAS u32x4*)(CV + brow), g1 = *(const PG8_LAS u32x4*)(CV + brow + 4), u0 = *(const PG8_LAS u32x4*)(CV + brow + HALF), u1 = *(const PG8_LAS u32x4*)(CV + brow + HALF + 4);
#pragma unroll
          for (int i = 0; i < 4; ++i) { c1g[i] = __uint_as_float(g0[i] << 16); c2g[i] = __uint_as_float(g0[i] & 0xffff0000u); c1g[4 + i] = __uint_as_float(g1[i] << 16); c2g[4 + i] = __uint_as_float(g1[i] & 0xffff0000u);
              c1u[i] = __uint_as_float(u0[i] << 16); c2u[i] = __uint_as_float(u0[i] & 0xffff0000u); c1u[4 + i] = __uint_as_float(u1[i] << 16); c2u[4 + i] = __uint_as_float(u1[i] & 0xffff0000u); } }
#pragma unroll
        for (int ai = 0; ai < 2; ++ai)
#pragma unroll
            for (int m = 0; m < 4; ++m) {
                bf16_t* p = O + (size_t)(row0 + ai * HALF + m * 16) * ldo + col0;
                const float rs = rsv[ai][m], ms = msv[ai][m];
                float v[8];
#pragma unroll
                for (int n = 0; n < 2; ++n)
#pragma unroll
                    for (int i = 0; i < 4; ++i) { const int e = n * 4 + i; const float g = acc[ai][0][m][n][i] * rs - ms * c1g[e] + c2g[e], up = acc[ai][1][m][n][i] * rs - ms * c1u[e] + c2u[e]; v[e] = g * fast_sigmoid(g) * up; }
                u32x4 w; w.x = cvt_pk_bf16(v[0], v[1]); w.y = cvt_pk_bf16(v[2], v[3]); w.z = cvt_pk_bf16(v[4], v[5]); w.w = cvt_pk_bf16(v[6], v[7]);
                *(u32x4*)p = w;
            }
    }
};
struct EpiResid {
    static constexpr bool PERM = false, AFTER_DRAIN = false;
    float* X; bf16_t* PB; const float* stp; float* stn; const float* gp; const float* bp; float alpha, s;
    template <int AI, int M0, int NR>
    __device__ __forceinline__ void batch(const f32x4 (&acc)[2][2][4][2], int row0, int col0, int wr, int wc, int fr, int fq, PG8_LAS float* red, const PG8_LAS float* gl) const {
        f32x2 xh[NR][2][2], xl[NR][2][2], stv[NR];
#pragma unroll
        for (int mm = 0; mm < NR; ++mm) { const unsigned rr_ = (unsigned)(row0 + AI * HALF + (M0 + mm) * 16); stv[mm] = *(const f32x2*)(stp + (8u * rr_ + 2u * (unsigned)fq));
#pragma unroll
            for (int bj = 0; bj < 2; ++bj)
#pragma unroll
                for (int n = 0; n < 2; ++n) { const unsigned cc_ = (unsigned)(col0 + bj * HALF + n * 16);
                    xh[mm][bj][n] = *(const f32x2*)(PB + (rr_ * 1024u + cc_)); xl[mm][bj][n] = *(const f32x2*)((const bf16_t*)X + (rr_ * 2048u + 1024u + cc_)); } }
#pragma unroll
        for (int mm = 0; mm < NR; ++mm) { const int m = M0 + mm; const int row = row0 + AI * HALF + m * 16;
            float rs, ms; { f32x2 v = stv[mm]; v.x = xsum_rows(v.x); v.y = xsum_rows(v.y);
              const float mean = v.x * (1.0f / 1024.0f); const float var = v.y * (1.0f / 1024.0f) - mean * mean; rs = __builtin_amdgcn_rsqf(var + 1e-5f); ms = rs * mean; }
            const unsigned ro = (unsigned)row * 1024u + (unsigned)col0;
            float sm = 0.f, sq = 0.f;
#pragma unroll
            for (int bj = 0; bj < 2; ++bj)
#pragma unroll
                for (int n = 0; n < 2; ++n) { const unsigned hw0 = __float_as_uint(xh[mm][bj][n].x), hw1 = __float_as_uint(xh[mm][bj][n].y), lw0 = __float_as_uint(xl[mm][bj][n].x), lw1 = __float_as_uint(xl[mm][bj][n].y);
                    f32x4 x; x[0] = __uint_as_float(hw0 << 16) + __uint_as_float(lw0 << 16); x[1] = __uint_as_float(hw0 & 0xffff0000u) + __uint_as_float(lw0 & 0xffff0000u);
                    x[2] = __uint_as_float(hw1 << 16) + __uint_as_float(lw1 << 16); x[3] = __uint_as_float(hw1 & 0xffff0000u) + __uint_as_float(lw1 & 0xffff0000u);
                    const f32x4 gvv = *(const PG8_LAS f32x4*)(gl + bj * HALF + n * 16), bvv = *(const PG8_LAS f32x4*)(gl + 1024 + bj * HALF + n * 16);
                    const f32x4 xn = (x * rs - ms) * gvv + bvv; const f32x4 y = xn * alpha + acc[AI][bj][m][n] * s;
                    const unsigned nh0 = cvt_pk_bf16(y[0], y[1]), nh1 = cvt_pk_bf16(y[2], y[3]);
                    f32x2 w; w.x = __uint_as_float(nh0); w.y = __uint_as_float(nh1); *(f32x2*)(PB + (ro + (unsigned)(bj * HALF + n * 16))) = w;
                    f32x2 wl; wl.x = __uint_as_float(cvt_pk_bf16(y[0] - __uint_as_float(nh0 << 16), y[1] - __uint_as_float(nh0 & 0xffff0000u))); wl.y = __uint_as_float(cvt_pk_bf16(y[2] - __uint_as_float(nh1 << 16), y[3] - __uint_as_float(nh1 & 0xffff0000u)));
                    *(f32x2*)((bf16_t*)X + ((unsigned)row * 2048u + 1024u + (unsigned)(col0 + bj * HALF + n * 16))) = wl;
                    sm += (y[0] + y[1]) + (y[2] + y[3]); sq += (y[0] * y[0] + y[1] * y[1]) + (y[2] * y[2] + y[3] * y[3]); }
            sm = xsum_rows(sm); sq = xsum_rows(sq);
            if (fq == 0) { f32x2 pr; pr.x = sm; pr.y = sq; *(PG8_LAS f32x2*)(red + ((AI * HALF + wr * 64 + m * 16 + fr) * 4 + wc) * 2) = pr; }
        }
        asm volatile("" ::: "memory");
    }
    __device__ __forceinline__ void operator()(const f32x4 (&acc)[2][2][4][2], const Unit& u, int wr, int wc, int fr, int fq, PG8_LAS unsigned char* ldsb) const {
        const int row0 = u.pm * BM + wr * 64 + fr; const int col0 = u.pn * BM + wc * 32 + 4 * fq;
        PG8_LAS float* red = (PG8_LAS float*)(ldsb + 131072);
        const PG8_LAS float* gl = (const PG8_LAS float*)(ldsb + 147456) + col0;
        batch<0, 0, 2>(acc, row0, col0, wr, wc, fr, fq, red, gl);
        batch<0, 2, 2>(acc, row0, col0, wr, wc, fr, fq, red, gl);
        batch<1, 0, 4>(acc, row0, col0, wr, wc, fr, fq, red, gl);
        asm volatile("s_waitcnt lgkmcnt(0)" ::: "memory"); __builtin_amdgcn_s_barrier(); asm volatile("" ::: "memory");
        { const int t = wr * 256 + wc * 64 + fq * 16 + fr;
          if (t < 256) { const PG8_LAS f32x4* rr = (const PG8_LAS f32x4*)(red + t * 8); const f32x4 a = rr[0], b = rr[1];
              f32x2 o; o.x = (a[0] + a[2]) + (b[0] + b[2]); o.y = (a[1] + a[3]) + (b[1] + b[3]); *(f32x2*)(stn + 8 * (size_t)(u.pm * BM + t) + 2 * u.pn) = o; } }
    }
};
struct EpiStore {
    static constexpr bool PERM = true, AFTER_DRAIN = false;
    bf16_t* O; int ldc; LnFix ln;
    __device__ __forceinline__ void operator()(const f32x4 (&acc)[2][2][4][2], const Unit& u, int wr, int wc, int fr, int fq, PG8_LAS unsigned char* ldsb) const {
        const int row0 = u.pm * BM + wr * 64 + fr; const int col0 = u.pn * BM + wc * 32 + 8 * fq;
        const bool has_ln = ln.st != nullptr;
        f32x4 c1v[2][2], c2v[2][2]; float rsv[2][4], msv[2][4];
#pragma unroll
        for (int ai = 0; ai < 2; ++ai)
#pragma unroll
            for (int m = 0; m < 4; ++m) { rsv[ai][m] = 1.f; msv[ai][m] = 0.f; }
#pragma unroll
        for (int bj = 0; bj < 2; ++bj)
#pragma unroll
            for (int n = 0; n < 2; ++n) { c1v[bj][n] = (f32x4){0.f, 0.f, 0.f, 0.f}; c2v[bj][n] = (f32x4){0.f, 0.f, 0.f, 0.f}; }
        if (has_ln) {
            const PG8_LAS unsigned* CV = (const PG8_LAS unsigned*)(ldsb + 131072);
            PG8_LAS f32x2* ST = (PG8_LAS f32x2*)(ldsb + 153600);
            volatile PG8_LAS int* TAG = (volatile PG8_LAS int*)(ldsb + 155648);
            if (TAG[wr] != u.pm) {
#pragma unroll
                for (int ai = 0; ai < 2; ++ai)
#pragma unroll
                    for (int m = 0; m < 4; ++m) { ln_row(ln.st, row0 + ai * HALF + m * 16, fq, rsv[ai][m], msv[ai][m]);
                        f32x2 pr; pr.x = rsv[ai][m]; pr.y = msv[ai][m]; ST[ai * HALF + wr * 64 + m * 16 + fr] = pr; }
                asm volatile("s_waitcnt lgkmcnt(0)" ::: "memory");
                TAG[wr] = u.pm;
            } else {
#pragma unroll
                for (int ai = 0; ai < 2; ++ai)
#pragma unroll
                    for (int m = 0; m < 4; ++m) { const f32x2 pr = ST[ai * HALF + wr * 64 + m * 16 + fr]; rsv[ai][m] = pr.x; msv[ai][m] = pr.y; }
            }
#pragma unroll
            for (int bj = 0; bj < 2; ++bj)
#pragma unroll
                for (int n = 0; n < 2; ++n) { const u32x4 cw = *(const PG8_LAS u32x4*)(CV + col0 + bj * HALF + 4 * n);
#pragma unroll
                    for (int i = 0; i < 4; ++i) { c1v[bj][n][i] = __uint_as_float(cw[i] << 16); c2v[bj][n][i] = __uint_as_float(cw[i] & 0xffff0000u); } }
        }
#pragma unroll
        for (int ai = 0; ai < 2; ++ai)
#pragma unroll
            for (int m = 0; m < 4; ++m) {
                bf16_t* rowp = O + (size_t)(row0 + ai * HALF + m * 16) * ldc + col0;
                const float rs = rsv[ai][m], ms = msv[ai][m];
#pragma unroll
                for (int bj = 0; bj < 2; ++bj) { const f32x4 v0 = acc[ai][bj][m][0] * rs - c1v[bj][0] * ms + c2v[bj][0], v1 = acc[ai][bj][m][1] * rs - c1v[bj][1] * ms + c2v[bj][1];
                    u32x4 w; w.x = cvt_pk_bf16(v0[0], v0[1]); w.y = cvt_pk_bf16(v0[2], v0[3]); w.z = cvt_pk_bf16(v1[0], v1[1]); w.w = cvt_pk_bf16(v1[2], v1[3]);
                    *(u32x4*)(rowp + bj * HALF) = w; }
            }
    }
};
struct EpiLru {
    static constexpr bool PERM = true, AFTER_DRAIN = false;
    unsigned* AB; const bf16_t* XC; const float* gb; const float* lam;
    __device__ __forceinline__ void operator()(const f32x4 (&acc)[2][2][4][2], const Unit& u, int wr, int wc, int fr, int fq, PG8_LAS unsigned char* ldsb) const {
        const int row0 = u.pm * BM + wr * 64 + fr; const int ch0 = u.pn * HALF + wc * 32 + 8 * fq;
        float sp[8], br[8], bi[8];
#pragma unroll
        for (int i = 0; i < 8; ++i) { sp[i] = lam[ch0 + i]; br[i] = gb[ch0 + i]; bi[i] = gb[512 + ch0 + i]; }
        u32x4 xwv[2][4];
#pragma unroll
        for (int ai = 0; ai < 2; ++ai)
#pragma unroll
            for (int m = 0; m < 4; ++m) xwv[ai][m] = *(const u32x4*)(XC + ((unsigned)(row0 + ai * HALF + m * 16) * 512u + (unsigned)ch0));
#pragma unroll
        for (int ai = 0; ai < 2; ++ai)
#pragma unroll
            for (int m = 0; m < 4; ++m) {
                const size_t ro = (size_t)(row0 + ai * HALF + m * 16) * 512 + ch0;
                const u32x4 xw = xwv[ai][m];
                unsigned ow[8];
#pragma unroll
                for (int n = 0; n < 2; ++n)
#pragma unroll
                    for (int i = 0; i < 4; ++i) { const int e = n * 4 + i;
                        const unsigned wd = xw[e >> 1]; const float xc = __uint_as_float((e & 1) ? (wd & 0xffff0000u) : (wd << 16));
                        const float r = fast_sigmoid(acc[ai][0][m][n][i] + br[e]), ig = fast_sigmoid(acc[ai][1][m][n][i] + bi[e]);
                        const float la = sp[e] * r;
                        const float bb = __builtin_sqrtf(fmaxf(1.0f - __expf(2.0f * la), 0.f)) * (ig * xc);
                        ow[e] = cvt_pk_bf16(la * 1.4426950408889634f, bb); }
                u32x4 w0, w1; w0.x = ow[0]; w0.y = ow[1]; w0.z = ow[2]; w0.w = ow[3]; w1.x = ow[4]; w1.y = ow[5]; w1.z = ow[6]; w1.w = ow[7];
                *(u32x4*)(AB + ro) = w0; *(u32x4*)(AB + ro + 4) = w1;
            }
    }
};
struct EpiGlu {
    static constexpr bool PERM = true, AFTER_DRAIN = false;
    bf16_t* O; int ldo; const bf16_t* Zs; const float* bias;
    __device__ __forceinline__ void operator()(const f32x4 (&acc)[2][2][4][2], const Unit& u, int wr, int wc, int fr, int fq, PG8_LAS unsigned char* ldsb) const {
        const int row0 = u.pm * BM + wr * 64 + fr; const int col0 = u.pn * BM + wc * 32 + 8 * fq;
#pragma unroll
        for (int ai = 0; ai < 2; ++ai) {
            u32x4 zv[4][2];
#pragma unroll
            for (int m = 0; m < 4; ++m)
#pragma unroll
                for (int bj = 0; bj < 2; ++bj) zv[m][bj] = *(const u32x4*)(Zs + ((unsigned)(row0 + ai * HALF + m * 16) * 512u + (unsigned)(col0 + bj * HALF)));
#pragma unroll
            for (int m = 0; m < 4; ++m) {
                const int row = row0 + ai * HALF + m * 16;
#pragma unroll
                for (int bj = 0; bj < 2; ++bj) {
                    const int c = col0 + bj * HALF;
                    const u32x4 zw = zv[m][bj];
                    float v[8];
#pragma unroll
                    for (int n = 0; n < 2; ++n)
#pragma unroll
                        for (int i = 0; i < 4; ++i) { const int e = n * 4 + i; const unsigned wd = zw[e >> 1];
                            const float z = __uint_as_float((e & 1) ? (wd & 0xffff0000u) : (wd << 16));
                            v[e] = z * fast_sigmoid(acc[ai][bj][m][n][i] + bias[c + e]); }
                    u32x4 w; w.x = cvt_pk_bf16(v[0], v[1]); w.y = cvt_pk_bf16(v[2], v[3]); w.z = cvt_pk_bf16(v[4], v[5]); w.w = cvt_pk_bf16(v[6], v[7]);
                    *(u32x4*)(O + (size_t)row * ldo + c) = w;
                }
            }
            asm volatile("" ::: "memory");
        }
    }
};
template <class Epi, class Sched, bool ALIGN_EPI = false, bool SP2 = false>
__device__ __forceinline__ void gemm_phase(PG8_LAS unsigned char* lds, const Gemm g, const Sched& S, const Epi& E) {
    int tid_ = threadIdx.x; asm volatile("" : "+v"(tid_)); const int tid = tid_, wid = __builtin_amdgcn_readfirstlane(tid >> 6), lane = tid & 63, wr = wid >> 2, wc = wid & 3, fr = lane & 15, fq = lane >> 4;
    const bf16_t* gA_ = g.A; const bf16_t* gB_ = g.Bt; int K = g.K; asm volatile("" : "+s"(gA_), "+s"(gB_), "+s"(K)); const int nt = K / BK;
    unsigned voffA[2], voffB[2];
#pragma unroll
    for (int i = 0; i < 2; ++i) { int R, C; stage_rc(tid * 16 + i * 8192, R, C); const int Rb = Epi::PERM ? ((R & ~31) + perm32(R & 31)) : R;
        voffA[i] = (unsigned)(R * K + C) * 2u; voffB[i] = (unsigned)(Rb * K + C) * 2u; }
    const size_t kstep = (size_t)(BK * 2);
    const size_t hstep = (size_t)HALF * K * 2;
    const size_t tstep = 2 * hstep;
    const unsigned ldsw = (unsigned)wid * 1024u;
    const int aoff = lds_byte(wr * 64 + fr, fq * 8), boff = lds_byte(wc * 32 + fr, fq * 8);
#define PG8_SA(b, h) (((b) * 2 + (h)) * HTB)
#define PG8_SB(b, h) ((4 + (b) * 2 + (h)) * HTB)
#define PG8_STAGE(bufoff, gbase, voff) do { _Pragma("unroll") for (int _i = 0; _i < 2; ++_i) \
        __builtin_amdgcn_global_load_lds((const unsigned*)((const char*)(gbase) + (voff)[_i]), (PG8_LAS unsigned*)(lds + (bufoff) + ldsw + _i * 8192), 16, 0, 0); } while (0)
#define PG8_LDA(dst, b, h) do { _Pragma("unroll") for (int m = 0; m < 4; ++m) _Pragma("unroll") for (int k = 0; k < 2; ++k) dst[m][k] = *(const PG8_LAS bf16x8*)(lds + PG8_SA(b, h) + aoff + m * 2048 + k * 1024); } while (0)
#define PG8_LDB(dst, b, h) do { _Pragma("unroll") for (int n = 0; n < 2; ++n) _Pragma("unroll") for (int k = 0; k < 2; ++k) dst[n][k] = *(const PG8_LAS bf16x8*)(lds + PG8_SB(b, h) + boff + n * 2048 + k * 1024); } while (0)
#define PG8_MMA(ai, bj, At, Bt) do { __builtin_amdgcn_s_setprio(1); _Pragma("unroll") for (int m = 0; m < 4; ++m) _Pragma("unroll") for (int n = 0; n < 2; ++n) _Pragma("unroll") for (int k = 0; k < 2; ++k) \
        acc[ai][bj][m][n] = __builtin_amdgcn_mfma_f32_16x16x32_bf16(Bt[n][k], At[m][k], acc[ai][bj][m][n], 0, 0, 0); __builtin_amdgcn_s_setprio(0); } while (0)
#define PG8_WAIT_V(n) asm volatile("s_waitcnt vmcnt(" #n ")" ::: "memory")
#define PG8_WAIT_L(n) asm volatile("s_waitcnt lgkmcnt(" #n ")" ::: "memory")
#define PG8_BAR __builtin_amdgcn_s_barrier()
#define PG8_SCHED __builtin_amdgcn_sched_barrier(0)
    Unit cur, nxt; int ui = 0;
    if (!S.next(0, cur)) return;
    f32x4 acc[2][2][4][2];
#pragma unroll
    for (int a = 0; a < 2; ++a)
#pragma unroll
        for (int b = 0; b < 2; ++b)
#pragma unroll
            for (int m = 0; m < 4; ++m)
#pragma unroll
                for (int n = 0; n < 2; ++n) acc[a][b][m][n] = (f32x4){0.f, 0.f, 0.f, 0.f};
    bf16x8 At[4][2], B0[2][2], B1[2][2];
    const char* cA = (const char*)gA_ + (size_t)cur.pm * tstep; const char* cB = (const char*)gB_ + (size_t)cur.pn * tstep;
    S.a_ready(cur);
    if constexpr (SP2) {
        PG8_STAGE(PG8_SB(0, 0), cB, voffB); PG8_STAGE(PG8_SB(0, 1), cB + hstep, voffB); PG8_STAGE(PG8_SA(0, 0), cA, voffA); PG8_STAGE(PG8_SA(0, 1), cA + hstep, voffA);
        if (wr == 1) PG8_BAR;
        PG8_WAIT_V(2); PG8_BAR;
        PG8_STAGE(PG8_SB(1, 0), cB + kstep, voffB); PG8_STAGE(PG8_SA(1, 0), cA + kstep, voffA); PG8_STAGE(PG8_SB(1, 1), cB + hstep + kstep, voffB);
        PG8_WAIT_V(6); PG8_BAR;
    } else {
        PG8_STAGE(PG8_SB(0, 0), cB, voffB); PG8_STAGE(PG8_SA(0, 0), cA, voffA); PG8_STAGE(PG8_SB(0, 1), cB + hstep, voffB); PG8_STAGE(PG8_SA(0, 1), cA + hstep, voffA);
        if (wr == 1) PG8_BAR;
        PG8_WAIT_V(4); PG8_BAR;
        PG8_STAGE(PG8_SB(1, 0), cB + kstep, voffB); PG8_STAGE(PG8_SA(1, 0), cA + kstep, voffA); PG8_STAGE(PG8_SB(1, 1), cB + hstep + kstep, voffB);
        PG8_WAIT_V(6); PG8_BAR;
    }
    for (;;) {
        const bool has_next = S.next(ui + 1, nxt);
        const char* nA = has_next ? (const char*)gA_ + (size_t)nxt.pm * tstep : cA; const char* nB = has_next ? (const char*)gB_ + (size_t)nxt.pn * tstep : cB;
        for (int t = 0; t < nt; t += 2) {
            const bool last = (t == nt - 2);
            const char* a1 = cA + (size_t)(t + 1) * kstep;
            const char* a2 = last ? nA : cA + (size_t)(t + 2) * kstep; const char* b2 = last ? nB : cB + (size_t)(t + 2) * kstep;
            const char* a3 = a2 + kstep; const char* b3 = b2 + kstep;
            if (last && has_next) S.a_ready(nxt);
            if constexpr (SP2) {
            PG8_LDB(B0, 0, 0); PG8_LDB(B1, 0, 1); PG8_SCHED; PG8_LDA(At, 0, 0); PG8_STAGE(PG8_SA(1, 1), a1 + hstep, voffA);
            PG8_WAIT_V(8); PG8_WAIT_L(0); PG8_BAR; PG8_MMA(0, 0, At, B0); PG8_MMA(0, 1, At, B1); PG8_BAR; PG8_SCHED;
            PG8_LDA(At, 0, 1); PG8_STAGE(PG8_SB(0, 0), b2, voffB); PG8_STAGE(PG8_SB(0, 1), b2 + hstep, voffB); PG8_STAGE(PG8_SA(0, 0), a2, voffA);
            PG8_WAIT_V(8); PG8_WAIT_L(0); PG8_BAR; PG8_MMA(1, 0, At, B0); PG8_MMA(1, 1, At, B1); PG8_BAR; PG8_SCHED;
            PG8_LDB(B0, 1, 0); PG8_LDB(B1, 1, 1); PG8_SCHED; PG8_LDA(At, 1, 0); PG8_STAGE(PG8_SA(0, 1), a2 + hstep, voffA);
            PG8_WAIT_V(8); PG8_WAIT_L(0); PG8_BAR; PG8_MMA(0, 0, At, B0); PG8_MMA(0, 1, At, B1); PG8_BAR; PG8_SCHED;
            PG8_LDA(At, 1, 1); PG8_STAGE(PG8_SB(1, 0), b3, voffB); PG8_STAGE(PG8_SB(1, 1), b3 + hstep, voffB); PG8_STAGE(PG8_SA(1, 0), a3, voffA);
            PG8_WAIT_V(8); PG8_WAIT_L(0); PG8_BAR; PG8_MMA(1, 0, At, B0); PG8_MMA(1, 1, At, B1); PG8_BAR; PG8_SCHED;
            } else {
            PG8_LDB(B0, 0, 0); PG8_SCHED; PG8_LDA(At, 0, 0); PG8_STAGE(PG8_SA(1, 1), a1 + hstep, voffA);
            PG8_WAIT_L(8); PG8_BAR; PG8_WAIT_L(0); PG8_MMA(0, 0, At, B0); PG8_BAR; PG8_SCHED;
            PG8_LDB(B1, 0, 1); PG8_STAGE(PG8_SB(0, 0), b2, voffB);
            PG8_BAR; PG8_WAIT_L(0); PG8_MMA(0, 1, At, B1); PG8_BAR;
            PG8_LDA(At, 0, 1); PG8_STAGE(PG8_SA(0, 0), a2, voffA);
            PG8_BAR; PG8_WAIT_L(0); PG8_MMA(1, 0, At, B0); PG8_BAR; PG8_SCHED;
            PG8_STAGE(PG8_SB(0, 1), b2 + hstep, voffB);
            PG8_WAIT_V(6); PG8_BAR; PG8_MMA(1, 1, At, B1); PG8_BAR;
            PG8_LDB(B0, 1, 0); PG8_SCHED; PG8_LDA(At, 1, 0); PG8_STAGE(PG8_SA(0, 1), a2 + hstep, voffA);
            PG8_WAIT_L(8); PG8_BAR; PG8_WAIT_L(0); PG8_MMA(0, 0, At, B0); PG8_BAR; PG8_SCHED;
            PG8_LDB(B1, 1, 1); PG8_STAGE(PG8_SB(1, 0), b3, voffB);
            PG8_BAR; PG8_WAIT_L(0); PG8_MMA(0, 1, At, B1); PG8_BAR;
            PG8_LDA(At, 1, 1); PG8_STAGE(PG8_SA(1, 0), a3, voffA);
            PG8_BAR; PG8_WAIT_L(0); PG8_MMA(1, 0, At, B0); PG8_BAR; PG8_SCHED;
            PG8_STAGE(PG8_SB(1, 1), b3 + hstep, voffB);
            PG8_WAIT_V(6); PG8_BAR; PG8_MMA(1, 1, At, B1); PG8_BAR;
            }
        }
        if constexpr (ALIGN_EPI) { if (wr == 0) PG8_BAR; }
        if constexpr (!Epi::AFTER_DRAIN) { E(acc, cur, wr, wc, fr, fq, lds); S.done(cur); }
        if (!has_next) break;
#pragma unroll
        for (int a = 0; a < 2; ++a)
#pragma unroll
            for (int b = 0; b < 2; ++b)
#pragma unroll
                for (int m = 0; m < 4; ++m)
#pragma unroll
                    for (int n = 0; n < 2; ++n) acc[a][b][m][n] = (f32x4){0.f, 0.f, 0.f, 0.f};
        cur = nxt; cA = nA; cB = nB; ++ui;
        if constexpr (ALIGN_EPI) { if (wr == 1) PG8_BAR; }
    }
    PG8_WAIT_V(0);
    if constexpr (!ALIGN_EPI) { if (wr == 0) PG8_BAR; }
    PG8_BAR;
    if constexpr (Epi::AFTER_DRAIN) { E.fused(acc, cur, wr, wc, fr, fq, lds, wid, lane); S.done(cur); }
#undef PG8_SA
#undef PG8_SB
#undef PG8_STAGE
#undef PG8_LDA
#undef PG8_LDB
#undef PG8_MMA
#undef PG8_WAIT_V
#undef PG8_WAIT_L
#undef PG8_BAR
#undef PG8_SCHED
}
}
#define LAS __attribute__((address_space(3)))
typedef unsigned short bf16_t;
typedef short bf16x8 __attribute__((ext_vector_type(8)));
typedef float f32x4 __attribute__((ext_vector_type(4)));
typedef float f32x2 __attribute__((ext_vector_type(2)));
typedef unsigned u32x4 __attribute__((ext_vector_type(4)));
using pg8::cvt_pk_bf16;

constexpr int T_TOK = 65536, DM = 1024, SEQ = 2048, NBATCH = 32, DFF = 2816, ZW = 2560, MEMT = 8192;
constexpr float DN_ALPHA = 1.681792830507429f, LN_EPS = 1e-5f, LOG2E = 1.4426950408889634f;
constexpr size_t SZ_W1 = (size_t)5632 * 1024, SZ_W2 = (size_t)1024 * 2816;
constexpr size_t OFF_W1 = 0, OFF_W2 = 2 * SZ_W1, OFF_WQ = OFF_W2 + 2 * SZ_W2, OFF_WKV = OFF_WQ + 1048576, OFF_WO = OFF_WKV + 2097152,
                 OFF_WIN = OFF_WO + 1048576, OFF_WOUT = OFF_WIN + 2621440, OFF_WEX = OFF_WOUT + 1048576, LAYER_W = OFF_WEX + 524288;
static_assert(LAYER_W * 2 == (size_t)49 << 20, "layer weights = 49 MiB");
constexpr size_t MiB = 1u << 20;
constexpr size_t WS_STATS = 1016 * MiB, WS_CVEC = 198 * MiB, WS_ONES = 198 * MiB + 786432, WS_ZEROS = 198 * MiB + 790528, CVEC_STRIDE = 2 * 5632, WS_SPL = 1 * MiB + 917504, WS_ROPE_DA = 1 * MiB, WS_ROPE_RET = 1 * MiB + 131072, WS_W = 2 * MiB, WS_MEMB = 200 * MiB, WS_XB = 216 * MiB, WS_BIG = 344 * MiB,
                 WS_CAT = 696 * MiB, WS_AUX = 824 * MiB, WS_AUX2 = 952 * MiB, WS_END = 1024 * MiB;
constexpr int LDS_BYTES = 156160;

struct Params { const float* in[32]; float* out; unsigned char* ws; };

__device__ __forceinline__ float bflo(unsigned w) { return __uint_as_float(w << 16); }
__device__ __forceinline__ float bfhi(unsigned w) { return __uint_as_float(w & 0xffff0000u); }
__device__ __forceinline__ unsigned short f2bf(float f) { return (unsigned short)(cvt_pk_bf16(f, 0.f) & 0xffffu); }
__device__ __forceinline__ float gelu_tanh(float x) { const float t = 1.5957691216057308f * (x + 0.044715f * x * x * x); return x * __builtin_amdgcn_rcpf(1.0f + __expf(-t)); }
__device__ __forceinline__ float silu_f(float x) { return x * __builtin_amdgcn_rcpf(1.0f + __expf(-x)); }
#define WSYNC() asm volatile("s_waitcnt lgkmcnt(0)" ::: "memory")
__device__ __forceinline__ float wave_sum(float v) {
    int self = (int)__builtin_amdgcn_mbcnt_hi(~0u, __builtin_amdgcn_mbcnt_lo(~0u, 0u)); asm volatile("" : "+v"(self));
#pragma unroll
    for (int o = 1; o < 16; o <<= 1) v += __int_as_float(__builtin_amdgcn_ds_bpermute((self ^ o) << 2, __float_as_int(v)));
    return xsum_rows(v);
}
__device__ __forceinline__ float red16(float v) { v += __shfl_xor(v, 1); v += __shfl_xor(v, 2); v += __shfl_xor(v, 4); v += __shfl_xor(v, 8); return v; }
__device__ __forceinline__ float max16(float v) { v = fmaxf(v, __shfl_xor(v, 1)); v = fmaxf(v, __shfl_xor(v, 2)); v = fmaxf(v, __shfl_xor(v, 4)); v = fmaxf(v, __shfl_xor(v, 8)); return v; }
__device__ __forceinline__ void sincos_acc(float angf, float& s, float& c) {
    const double x = (double)angf; const double k = rint(x * 0.15915494309189535); const double r = fma(-k, 6.283185307179586, x);
    const double r2 = r * r; double ts = r, tc = 1.0, ss = r, cc = 1.0;
#pragma unroll
    for (int n = 1; n <= 14; ++n) { tc *= -r2 * (1.0 / (double)((2 * n - 1) * (2 * n))); cc += tc; ts *= -r2 * (1.0 / (double)((2 * n) * (2 * n + 1))); ss += ts; }
    s = (float)ss; c = (float)cc;
}

__device__ __forceinline__ void transpose_mat(const float* W, int K, int N, bf16_t* WT, int mode, int row_off, LAS float* scr, int gw, int NGW, int lane, int& base_item, const float* gs = nullptr) {
    const int nblk = N / 32, items = (K / 64) * nblk;
    int first = (gw - (base_item % NGW) + NGW) % NGW;
    for (int item = first; item < items; item += NGW) {
        const int kb = item / nblk, nb = item % nblk, k0 = 64 * kb, n0 = 32 * nb;
        const int rowbase = mode ? ((n0 >> 7) * 256 + row_off + (n0 & 127)) : (row_off + n0);
#pragma unroll
        for (int i = 0; i < 32; ++i) { const int kk = 2 * i + (lane >> 5); const float sc_ = gs ? gs[k0 + kk] : 1.0f; scr[kk * 33 + (lane & 31)] = W[(size_t)(k0 + kk) * N + n0 + (lane & 31)] * sc_; }
        WSYNC();
        const int c = lane & 7;
#pragma unroll
        for (int j = 0; j < 4; ++j) { const int n = (lane >> 3) + 8 * j; const LAS float* s = scr + (8 * c) * 33 + n;
            u32x4 o; o.x = cvt_pk_bf16(s[0 * 33], s[1 * 33]); o.y = cvt_pk_bf16(s[2 * 33], s[3 * 33]); o.z = cvt_pk_bf16(s[4 * 33], s[5 * 33]); o.w = cvt_pk_bf16(s[6 * 33], s[7 * 33]);
            *(u32x4*)(WT + (size_t)(rowbase + n) * K + k0 + 8 * c) = o; }
        WSYNC();
    }
    base_item += items;
}

typedef unsigned u32x2 __attribute__((ext_vector_type(2)));
template <int D, int DV, int MODE, int NMAP>
__device__ __forceinline__ void attn_core2(LAS unsigned char* lds, const bf16_t* Qp, int ldq, const bf16_t* Kp, int ldk, const bf16_t* Vp, int ldv,
                                           int q0, int nkt, float sc, float l2g, f32x4 (&o)[NMAP][DV / 16], float (&l)[NMAP]) {
    constexpr int DT = NMAP * D, KSTR = DT + 8, VSTR = 72, KS_BYTES = 64 * KSTR * 2, KN = DT / 64, VN = DV / 64;
    int tid_ = threadIdx.x; asm volatile("" : "+v"(tid_)); const int tid = tid_, lane = tid & 63, w = __builtin_amdgcn_readfirstlane(tid >> 6), r = lane & 15, g4 = lane >> 4;
    LAS bf16_t* Ks = (LAS bf16_t*)lds; LAS bf16_t* Vt = (LAS bf16_t*)(lds + KS_BYTES);
    bf16x8 qf[NMAP][D / 32];
    { const bf16_t* qr = Qp + (size_t)(w * 16 + r) * ldq + g4 * 8;
#pragma unroll
      for (int mp = 0; mp < NMAP; ++mp)
#pragma unroll
        for (int kk = 0; kk < D / 32; ++kk) qf[mp][kk] = *(const bf16x8*)(qr + mp * D + kk * 32); }
    float m[NMAP];
#pragma unroll
    for (int mp = 0; mp < NMAP; ++mp) { m[mp] = -INFINITY; l[mp] = 0.f;
#pragma unroll
        for (int cb = 0; cb < DV / 16; ++cb) o[mp][cb] = (f32x4){0.f, 0.f, 0.f, 0.f}; }
    const int rowmin = q0 + w * 16, myrow = rowmin + r;
    u32x4 kreg[KN], vreg[VN];
#pragma unroll
    for (int i = 0; i < KN; ++i) { const int c = tid + i * 512; const int key = c / (DT / 8), ch = c % (DT / 8); kreg[i] = *(const u32x4*)(Kp + (size_t)key * ldk + ch * 8); }
#pragma unroll
    for (int i = 0; i < VN; ++i) { const int c = w + i * 8; vreg[i] = *(const u32x4*)(Vp + (size_t)lane * ldv + c * 8); }
    for (int kt = 0; kt < nkt; ++kt) {
        __syncthreads();
#pragma unroll
        for (int i = 0; i < KN; ++i) { const int c = tid + i * 512; const int key = c / (DT / 8), ch = c % (DT / 8); *(LAS u32x4*)(Ks + key * KSTR + ch * 8) = kreg[i]; }
#pragma unroll
        for (int i = 0; i < VN; ++i) { const int c = w + i * 8; const u32x4 v = vreg[i];
            LAS bf16_t* d = Vt + (c * 8) * VSTR + lane;
            d[0 * VSTR] = (bf16_t)(v.x & 0xffffu); d[1 * VSTR] = (bf16_t)(v.x >> 16); d[2 * VSTR] = (bf16_t)(v.y & 0xffffu); d[3 * VSTR] = (bf16_t)(v.y >> 16);
            d[4 * VSTR] = (bf16_t)(v.z & 0xffffu); d[5 * VSTR] = (bf16_t)(v.z >> 16); d[6 * VSTR] = (bf16_t)(v.w & 0xffffu); d[7 * VSTR] = (bf16_t)(v.w >> 16); }
        __syncthreads();
        if (kt + 1 < nkt) {
#pragma unroll
            for (int i = 0; i < KN; ++i) { const int c = tid + i * 512; const int key = c / (DT / 8), ch = c % (DT / 8); kreg[i] = *(const u32x4*)(Kp + (size_t)((kt + 1) * 64 + key) * ldk + ch * 8); }
#pragma unroll
            for (int i = 0; i < VN; ++i) { const int c = w + i * 8; vreg[i] = *(const u32x4*)(Vp + (size_t)((kt + 1) * 64 + lane) * ldv + c * 8); }
        }
        if (MODE == 0 || kt * 64 <= rowmin + 15) {
            bf16x8 pb[NMAP][2];
#pragma unroll
            for (int mp = 0; mp < NMAP; ++mp) {
                f32x4 s[4];
#pragma unroll
                for (int nb = 0; nb < 4; ++nb) { s[nb] = (f32x4){0.f, 0.f, 0.f, 0.f};
#pragma unroll
                    for (int kk = 0; kk < D / 32; ++kk) { const bf16x8 kf = *(const LAS bf16x8*)(Ks + (nb * 16 + r) * KSTR + mp * D + kk * 32 + g4 * 8);
                        s[nb] = __builtin_amdgcn_mfma_f32_16x16x32_bf16(kf, qf[mp][kk], s[nb], 0, 0, 0); } }
                if (MODE < 2) {
                    float mx = -INFINITY;
#pragma unroll
                    for (int nb = 0; nb < 4; ++nb)
#pragma unroll
                        for (int j = 0; j < 4; ++j) { float x = s[nb][j] * sc;
                            if (MODE == 1) { const int key = kt * 64 + nb * 16 + g4 * 4 + j; if (key > myrow) x = -INFINITY; }
                            s[nb][j] = x; mx = fmaxf(mx, x); }
                    mx = xmax_rows(mx);
                    const float mn = fmaxf(m[mp], mx); const float al = __builtin_amdgcn_exp2f(m[mp] - mn); m[mp] = mn;
                    float ps = 0.f;
#pragma unroll
                    for (int nb = 0; nb < 4; ++nb)
#pragma unroll
                        for (int j = 0; j < 4; ++j) { const float p = __builtin_amdgcn_exp2f(s[nb][j] - mn); ps += p; s[nb][j] = p; }
                    l[mp] = l[mp] * al + ps;
#pragma unroll
                    for (int cb = 0; cb < DV / 16; ++cb) o[mp][cb] = o[mp][cb] * al;
                } else {
#pragma unroll
                    for (int nb = 0; nb < 4; ++nb)
#pragma unroll
                        for (int j = 0; j < 4; ++j) { const int dd = myrow - (kt * 64 + nb * 16 + g4 * 4 + j);
                            s[nb][j] = dd >= 0 ? s[nb][j] * __builtin_amdgcn_exp2f(l2g * (float)dd) : 0.f; }
                }
#pragma unroll
                for (int kk = 0; kk < 2; ++kk) { u32x4 wv; wv.x = cvt_pk_bf16(s[2 * kk][0], s[2 * kk][1]); wv.y = cvt_pk_bf16(s[2 * kk][2], s[2 * kk][3]);
                    wv.z = cvt_pk_bf16(s[2 * kk + 1][0], s[2 * kk + 1][1]); wv.w = cvt_pk_bf16(s[2 * kk + 1][2], s[2 * kk + 1][3]); pb[mp][kk] = __builtin_bit_cast(bf16x8, wv); }
            }
#pragma unroll
            for (int kk = 0; kk < 2; ++kk)
#pragma unroll
                for (int cb = 0; cb < DV / 16; ++cb) { const LAS bf16_t* vp = Vt + (cb * 16 + r) * VSTR + kk * 32 + g4 * 4;
                    const u32x2 lo = *(const LAS u32x2*)vp, hi = *(const LAS u32x2*)(vp + 16); u32x4 t; t.x = lo.x; t.y = lo.y; t.z = hi.x; t.w = hi.y;
                    const bf16x8 vf = __builtin_bit_cast(bf16x8, t);
#pragma unroll
                    for (int mp = 0; mp < NMAP; ++mp) o[mp][cb] = __builtin_amdgcn_mfma_f32_16x16x32_bf16(vf, pb[mp][kk], o[mp][cb], 0, 0, 0); }
        }
    }
    if (MODE < 2) {
#pragma unroll
        for (int mp = 0; mp < NMAP; ++mp) { l[mp] = xsum_rows(l[mp]); }
    }
}

template <int D, int DV, int MODE, int NMAP, int KT>
__device__ __forceinline__ void attn_core3(LAS unsigned char* lds, const bf16_t* Qp, int ldq, const bf16_t* Kp, int ldk, const bf16_t* Vp, int ldv,
                                           int q0, int nkt, float sc, float l2g, f32x4 (&o)[NMAP][DV / 16], float (&l)[NMAP]) {
    constexpr int DT = NMAP * D, KSTR = DT + 8, VSTR = KT + 8, KS_BYTES = KT * KSTR * 2, VT_BYTES = DV * VSTR * 2, BUF_BYTES = KS_BYTES + VT_BYTES, KN = KT * (DT / 8) / 512, VN = (DV / 8) * (KT / 64) / 8, NB = KT / 16, KK2 = KT / 32;
    int tid_ = threadIdx.x; asm volatile("" : "+v"(tid_)); const int tid = tid_, lane = tid & 63, w = __builtin_amdgcn_readfirstlane(tid >> 6), r = lane & 15, g4 = lane >> 4;
    bf16x8 qf[NMAP][D / 32];
    { const bf16_t* qr = Qp + (size_t)(w * 16 + r) * ldq + g4 * 8;
#pragma unroll
      for (int mp = 0; mp < NMAP; ++mp)
#pragma unroll
        for (int kk = 0; kk < D / 32; ++kk) qf[mp][kk] = *(const bf16x8*)(qr + mp * D + kk * 32); }
    float m[NMAP];
#pragma unroll
    for (int mp = 0; mp < NMAP; ++mp) { m[mp] = -INFINITY; l[mp] = 0.f;
#pragma unroll
        for (int cb = 0; cb < DV / 16; ++cb) o[mp][cb] = (f32x4){0.f, 0.f, 0.f, 0.f}; }
    const int rowmin = q0 + w * 16, myrow = rowmin + r;
    float ck[NB][4];
    if (MODE == 2) {
#pragma unroll
        for (int nb = 0; nb < NB; ++nb)
#pragma unroll
            for (int j = 0; j < 4; ++j) ck[nb][j] = __builtin_amdgcn_exp2f(-l2g * (float)(nb * 16 + g4 * 4 + j));
    }
    u32x4 kreg[KN], vreg[VN];
#define AT_LOAD(t) do { _Pragma("unroll") for (int i = 0; i < KN; ++i) { const int c = tid + i * 512; const int key = c / (DT / 8), ch = c % (DT / 8); kreg[i] = *(const u32x4*)(Kp + (size_t)((t) * KT + key) * ldk + ch * 8); } \
        _Pragma("unroll") for (int i = 0; i < VN; ++i) { const int it_ = w + i * 8; const int c = it_ % (DV / 8), kg = it_ / (DV / 8); vreg[i] = *(const u32x4*)(Vp + (size_t)((t) * KT + kg * 64 + lane) * ldv + c * 8); } } while (0)
#define AT_STORE(boff) do { LAS bf16_t* Ks_ = (LAS bf16_t*)(lds + (boff)); LAS bf16_t* Vt_ = (LAS bf16_t*)(lds + (boff) + KS_BYTES); \
        _Pragma("unroll") for (int i = 0; i < KN; ++i) { const int c = tid + i * 512; const int key = c / (DT / 8), ch = c % (DT / 8); *(LAS u32x4*)(Ks_ + key * KSTR + ch * 8) = kreg[i]; } \
        _Pragma("unroll") for (int i = 0; i < VN; ++i) { const int it_ = w + i * 8; const int c = it_ % (DV / 8), kg = it_ / (DV / 8); const u32x4 v = vreg[i]; LAS bf16_t* d = Vt_ + (c * 8) * VSTR + kg * 64 + lane; \
            d[0 * VSTR] = (bf16_t)(v.x & 0xffffu); d[1 * VSTR] = (bf16_t)(v.x >> 16); d[2 * VSTR] = (bf16_t)(v.y & 0xffffu); d[3 * VSTR] = (bf16_t)(v.y >> 16); \
            d[4 * VSTR] = (bf16_t)(v.z & 0xffffu); d[5 * VSTR] = (bf16_t)(v.z >> 16); d[6 * VSTR] = (bf16_t)(v.w & 0xffffu); d[7 * VSTR] = (bf16_t)(v.w >> 16); } } while (0)
    AT_LOAD(0);
    __syncthreads();
    AT_STORE(0);
    if (nkt > 1) AT_LOAD(1);
    for (int kt = 0; kt < nkt; ++kt) {
        __syncthreads();
        const int cur = (kt & 1) * BUF_BYTES;
        if (kt + 1 < nkt) { AT_STORE(((kt + 1) & 1) * BUF_BYTES); if (kt + 2 < nkt) AT_LOAD(kt + 2); }
        if (MODE == 0 || kt * KT <= rowmin + 15) {
            const LAS bf16_t* Ks = (const LAS bf16_t*)(lds + cur); const LAS bf16_t* Vt = (const LAS bf16_t*)(lds + cur + KS_BYTES);
            const bool diag = (MODE != 0) && (kt * KT + KT - 1 > rowmin);
            bf16x8 pb[NMAP][KK2];
            f32x4 sall[NMAP][NB];
#pragma unroll
            for (int mp = 0; mp < NMAP; ++mp) {
                f32x4 (&s)[NB] = sall[mp];
                constexpr int KD = D / 32, NBB = (KD >= 8) ? 1 : (8 / KD), NSB = NB / NBB;
                bf16x8 kfr[2][NBB][KD];
#define AT_SLOAD(bi_, sl_) do { _Pragma("unroll") for (int x_ = 0; x_ < NBB; ++x_) _Pragma("unroll") for (int kk = 0; kk < KD; ++kk) \
                    kfr[sl_][x_][kk] = *(const LAS bf16x8*)(Ks + (((bi_) * NBB + x_) * 16 + r) * KSTR + mp * D + kk * 32 + g4 * 8); } while (0)
                AT_SLOAD(0, 0);
#pragma unroll
                for (int bi = 0; bi < NSB; ++bi) {
                    if (bi + 1 < NSB) AT_SLOAD(bi + 1, (bi + 1) & 1);
                    __builtin_amdgcn_sched_barrier(0);
                    __builtin_amdgcn_s_setprio(1);
#pragma unroll
                    for (int x_ = 0; x_ < NBB; ++x_) { const int nb = bi * NBB + x_;
                        s[nb] = __builtin_amdgcn_mfma_f32_16x16x32_bf16(kfr[bi & 1][x_][0], qf[mp][0], (f32x4){0.f, 0.f, 0.f, 0.f}, 0, 0, 0);
#pragma unroll
                        for (int kk = 1; kk < KD; ++kk) s[nb] = __builtin_amdgcn_mfma_f32_16x16x32_bf16(kfr[bi & 1][x_][kk], qf[mp][kk], s[nb], 0, 0, 0); }
                    __builtin_amdgcn_s_setprio(0);
                    __builtin_amdgcn_sched_barrier(0);
                }
#undef AT_SLOAD
            }
#pragma unroll
            for (int mp = 0; mp < NMAP; ++mp) {
                f32x4 (&s)[NB] = sall[mp];
                if (MODE < 2) {
                    if (diag) {
#pragma unroll
                        for (int nb = 0; nb < NB; ++nb)
#pragma unroll
                            for (int j = 0; j < 4; ++j) { if (kt * KT + nb * 16 + g4 * 4 + j > myrow) s[nb][j] = -INFINITY; }
                    }
                    float mx = fmaxf(fmaxf(s[0][0], s[0][1]), s[0][2]);
                    mx = fmaxf(fmaxf(mx, s[0][3]), s[1][0]); mx = fmaxf(fmaxf(mx, s[1][1]), s[1][2]); mx = fmaxf(fmaxf(mx, s[1][3]), s[2][0]);
                    mx = fmaxf(fmaxf(mx, s[2][1]), s[2][2]); mx = fmaxf(fmaxf(mx, s[2][3]), s[3][0]); mx = fmaxf(fmaxf(mx, s[3][1]), s[3][2]); mx = fmaxf(mx, s[3][3]);
#pragma unroll
                    for (int nb = 4; nb < NB; ++nb) { mx = fmaxf(fmaxf(mx, s[nb][0]), s[nb][1]); mx = fmaxf(fmaxf(mx, s[nb][2]), s[nb][3]); }
                    mx = xmax_rows(mx) * sc;
                    if (__any(mx > m[mp] + 6.0f)) {
                        const float mn = fmaxf(m[mp], mx); const float al = __builtin_amdgcn_exp2f(m[mp] - mn); m[mp] = mn; l[mp] *= al;
#pragma unroll
                        for (int cb = 0; cb < DV / 16; ++cb) o[mp][cb] = o[mp][cb] * al;
                    }
                    const float nm = -m[mp]; float ps = 0.f;
#pragma unroll
                    for (int nb = 0; nb < NB; ++nb)
#pragma unroll
                        for (int j = 0; j < 4; ++j) { const float p = __builtin_amdgcn_exp2f(fmaf(s[nb][j], sc, nm)); ps += p; s[nb][j] = p; }
                    l[mp] += ps;
                } else {
                    const float rowf = __builtin_amdgcn_exp2f(l2g * (float)(myrow - kt * KT));
#pragma unroll
                    for (int nb = 0; nb < NB; ++nb)
#pragma unroll
                        for (int j = 0; j < 4; ++j) { float p = s[nb][j] * (rowf * ck[nb][j]); if (diag && (kt * KT + nb * 16 + g4 * 4 + j > myrow)) p = 0.f; s[nb][j] = p; }
                }
#pragma unroll
                for (int kk = 0; kk < KK2; ++kk) { u32x4 wv; wv.x = cvt_pk_bf16(s[2 * kk][0], s[2 * kk][1]); wv.y = cvt_pk_bf16(s[2 * kk][2], s[2 * kk][3]);
                    wv.z = cvt_pk_bf16(s[2 * kk + 1][0], s[2 * kk + 1][1]); wv.w = cvt_pk_bf16(s[2 * kk + 1][2], s[2 * kk + 1][3]); pb[mp][kk] = __builtin_bit_cast(bf16x8, wv); }
            }
            {
                constexpr int CBB = 4, NCB = (DV / 16) / CBB, NVB = KK2 * NCB;
                bf16x8 vfr[2][CBB];
#define AT_VLOAD(b_, sl_) do { const int kk_ = (b_) / NCB, c0_ = ((b_) % NCB) * CBB; _Pragma("unroll") for (int x_ = 0; x_ < CBB; ++x_) { const LAS bf16_t* vp = Vt + ((c0_ + x_) * 16 + r) * VSTR + kk_ * 32 + g4 * 4; \
                    const u32x2 lo = *(const LAS u32x2*)vp, hi = *(const LAS u32x2*)(vp + 16); u32x4 t; t.x = lo.x; t.y = lo.y; t.z = hi.x; t.w = hi.y; vfr[sl_][x_] = __builtin_bit_cast(bf16x8, t); } } while (0)
                AT_VLOAD(0, 0);
#pragma unroll
                for (int b_ = 0; b_ < NVB; ++b_) {
                    if (b_ + 1 < NVB) AT_VLOAD(b_ + 1, (b_ + 1) & 1);
                    __builtin_amdgcn_sched_barrier(0);
                    const int kk_ = b_ / NCB, c0_ = (b_ % NCB) * CBB;
                    __builtin_amdgcn_s_setprio(1);
#pragma unroll
                    for (int x_ = 0; x_ < CBB; ++x_)
#pragma unroll
                        for (int mp = 0; mp < NMAP; ++mp) o[mp][c0_ + x_] = __builtin_amdgcn_mfma_f32_16x16x32_bf16(vfr[b_ & 1][x_], pb[mp][kk_], o[mp][c0_ + x_], 0, 0, 0);
                    __builtin_amdgcn_s_setprio(0);
                    __builtin_amdgcn_sched_barrier(0);
                }
#undef AT_VLOAD
            }
        }
    }
#undef AT_LOAD
#undef AT_STORE
    if (MODE < 2) {
#pragma unroll
        for (int mp = 0; mp < NMAP; ++mp) l[mp] = xsum_rows(l[mp]);
    }
}
constexpr int S5_LDS_WAVE = 28160;
__device__ __forceinline__ void s5_unit(LAS unsigned char* lw, int b, int g, const float* lam_re, const float* lam_im, const float* log_step,
                                        const float* b_re, const float* b_im, const float* c_re, const float* c_im, const float* d_skip,
                                        const bf16_t* Z, bf16_t* Z5, int lane) {
    const int n = lane, r = lane & 15, g4 = lane >> 4;
    LAS float* U = (LAS float*)lw; LAS bf16_t* H = (LAS bf16_t*)(lw + 2048); LAS float* Xs = (LAS float*)(lw + 2048 + 8704); LAS f32x2* Fs = (LAS f32x2*)(lw + 2048 + 8704 + 16896);
    const float step = expf(log_step[g]); const float lr = fminf(lam_re[g * 64 + n], -1e-4f), li = lam_im[g * 64 + n];
    const float mag = expf(lr * step); float sn, cs; sincos_acc(li * step, sn, cs);
    const float are = mag * cs, aim = mag * sn;
    { const float den = lr * lr + li * li, nr = are - 1.0f, ni = aim; Fs[n] = (f32x2){(nr * lr + ni * li) / den, (ni * lr - nr * li) / den}; }
    WSYNC();
    bf16x8 Bf[8];
#pragma unroll
    for (int nb = 0; nb < 8; ++nb) {
        const int ns = (nb & 3) * 16 + r; const f32x2 f = Fs[ns];
        u32x4 wv = (u32x4){0u, 0u, 0u, 0u};
        if (g4 < 2) {
            const f32x4 br0 = *(const f32x4*)(b_re + (size_t)(g * 64 + ns) * 16 + g4 * 8), br1 = *(const f32x4*)(b_re + (size_t)(g * 64 + ns) * 16 + g4 * 8 + 4);
            const f32x4 bi0 = *(const f32x4*)(b_im + (size_t)(g * 64 + ns) * 16 + g4 * 8), bi1 = *(const f32x4*)(b_im + (size_t)(g * 64 + ns) * 16 + g4 * 8 + 4);
            f32x4 v0, v1;
            if (nb < 4) { v0 = br0 * f.x - bi0 * f.y; v1 = br1 * f.x - bi1 * f.y; } else { v0 = bi0 * f.x + br0 * f.y; v1 = bi1 * f.x + br1 * f.y; }
            wv.x = cvt_pk_bf16(v0[0], v0[1]); wv.y = cvt_pk_bf16(v0[2], v0[3]); wv.z = cvt_pk_bf16(v1[0], v1[1]); wv.w = cvt_pk_bf16(v1[2], v1[3]);
        }
        Bf[nb] = __builtin_bit_cast(bf16x8, wv);
    }
    bf16x8 Cf[4];
#pragma unroll
    for (int kk = 0; kk < 4; ++kk)
#pragma unroll
        for (int e = 0; e < 8; ++e) { const int kf_ = kk * 32 + g4 * 8 + e, n_ = kf_ >> 1;
            const float v = (kf_ & 1) ? -c_im[(size_t)(g * 16 + r) * 64 + n_] : c_re[(size_t)(g * 16 + r) * 64 + n_];
            Cf[kk][e] = (short)f2bf(v); }
    const float dsk = d_skip[g * 16 + r];
    float hr = 0.f, hi = 0.f;
    const bf16_t* zb = Z + (size_t)b * SEQ * ZW + g * 16;
    bf16_t* ob = Z5 + (size_t)b * SEQ * 512 + g * 16;
    const int g4c = g4 < 2 ? g4 : 0;
    u32x4 vnext = *(const u32x4*)(zb + (size_t)(lane >> 1) * ZW + (lane & 1) * 8);
    u32x4 an0 = *(const u32x4*)(zb + (size_t)r * ZW + g4c * 8), an1 = *(const u32x4*)(zb + (size_t)(16 + r) * ZW + g4c * 8);
    for (int tc = 0; tc < SEQ / 32; ++tc) {
        const int t0 = tc * 32;
        u32x4 a0 = an0, a1 = an1; if (g4 >= 2) { a0 = (u32x4){0u, 0u, 0u, 0u}; a1 = a0; }
        { const int tk = lane >> 1, hf = lane & 1; const u32x4 v = vnext;
          if (tc + 1 < SEQ / 32) { vnext = *(const u32x4*)(zb + (size_t)(t0 + 32 + tk) * ZW + hf * 8);
              an0 = *(const u32x4*)(zb + (size_t)(t0 + 32 + r) * ZW + g4c * 8); an1 = *(const u32x4*)(zb + (size_t)(t0 + 48 + r) * ZW + g4c * 8); }
          f32x4 a, c2; a[0] = bflo(v.x); a[1] = bfhi(v.x); a[2] = bflo(v.y); a[3] = bfhi(v.y); c2[0] = bflo(v.z); c2[1] = bfhi(v.z); c2[2] = bflo(v.w); c2[3] = bfhi(v.w);
          *(LAS f32x4*)(U + tk * 16 + hf * 8) = a; *(LAS f32x4*)(U + tk * 16 + hf * 8 + 4) = c2; }
#pragma unroll
        for (int rb = 0; rb < 2; ++rb) { const bf16x8 af = __builtin_bit_cast(bf16x8, rb ? a1 : a0);
#pragma unroll
            for (int nb = 0; nb < 8; ++nb) { const f32x4 xa = __builtin_amdgcn_mfma_f32_16x16x32_bf16(af, Bf[nb], (f32x4){0.f, 0.f, 0.f, 0.f}, 0, 0, 0);
#pragma unroll
                for (int j = 0; j < 4; ++j) Xs[(rb * 16 + g4 * 4 + j) * 132 + nb * 16 + r] = xa[j]; } }
        WSYNC();
        {
            float xrv[32], xiv[32]; unsigned hp[32];
#pragma unroll
            for (int t = 0; t < 32; ++t) { xrv[t] = Xs[t * 132 + n]; xiv[t] = Xs[t * 132 + 64 + n]; }
            __builtin_amdgcn_sched_barrier(0);
#pragma unroll
            for (int t = 0; t < 32; ++t) { const float nhr = are * hr - aim * hi + xrv[t], nhi = are * hi + aim * hr + xiv[t]; hr = nhr; hi = nhi; hp[t] = cvt_pk_bf16(hr, hi); }
            __builtin_amdgcn_sched_barrier(0);
#pragma unroll
            for (int t = 0; t < 32; ++t) *(LAS unsigned*)(H + t * 136 + 2 * n) = hp[t];
        }
        WSYNC();
        {
            bf16x8 hf[2][4]; float uu[2][4];
#pragma unroll
            for (int rb = 0; rb < 2; ++rb) {
#pragma unroll
                for (int kk = 0; kk < 4; ++kk) hf[rb][kk] = *(const LAS bf16x8*)(H + (rb * 16 + r) * 136 + kk * 32 + g4 * 8);
#pragma unroll
                for (int j = 0; j < 4; ++j) uu[rb][j] = U[(rb * 16 + g4 * 4 + j) * 16 + r]; }
            __builtin_amdgcn_sched_barrier(0);
#pragma unroll
            for (int rb = 0; rb < 2; ++rb) {
                f32x4 acc = __builtin_amdgcn_mfma_f32_16x16x32_bf16(hf[rb][0], Cf[0], (f32x4){0.f, 0.f, 0.f, 0.f}, 0, 0, 0);
#pragma unroll
                for (int kk = 1; kk < 4; ++kk) acc = __builtin_amdgcn_mfma_f32_16x16x32_bf16(hf[rb][kk], Cf[kk], acc, 0, 0, 0);
#pragma unroll
                for (int j = 0; j < 4; ++j) { const int t = rb * 16 + g4 * 4 + j; const float y = acc[j] + dsk * uu[rb][j];
                    ob[(size_t)(t0 + t) * 512 + r] = f2bf(gelu_tanh(y)); }
            }
        }
        WSYNC();
    }
}

#define RLX_AGENT __ATOMIC_RELAXED, __HIP_MEMORY_SCOPE_AGENT
#define XB_TMO      128
#define XB_XCNT(j)  (256  + 64 * (j))
#define XB_XSUB(j)  (1280 + 64 * (j))
#define XB_XGEN(j)  (2304 + 64 * (j))
#define XB_TOP      3328
#define XB_TOPGEN   3392
#define XCD_BAR_WORDS 3456
#define XB_SPIN_CAP (1u << 18)

__device__ __forceinline__ unsigned xb_ld(unsigned* p)              { return __hip_atomic_load(p, __ATOMIC_RELAXED, __HIP_MEMORY_SCOPE_AGENT); }
__device__ __forceinline__ unsigned xb_add(unsigned* p, unsigned v) { return __hip_atomic_fetch_add(p, v, __ATOMIC_RELAXED, __HIP_MEMORY_SCOPE_AGENT); }
__device__ __forceinline__ unsigned xb_xcc_id() { return (unsigned)__builtin_amdgcn_s_getreg((3 << 11) | 20) & 0xFu; }
#define XB_SPIN(cond, bar) do { unsigned _sp = 0; while (cond) { __builtin_amdgcn_s_sleep(1); \
    if ((++_sp & 255u) == 0u) { if (xb_ld(&(bar)[XB_TMO])) break; if (_sp > XB_SPIN_CAP) { atomicAdd(&(bar)[XB_TMO], 1u); break; } } } } while (0)

struct XcdBarrier {
    unsigned* bar; unsigned x;
    volatile LAS unsigned* st;
};

__device__ __forceinline__ XcdBarrier xcd_barrier_post(unsigned* bar, volatile LAS unsigned* st) {
    XcdBarrier b; b.bar = bar; b.x = xb_xcc_id(); b.st = st;
    if (threadIdx.x == 0) (void)xb_add(&bar[XB_XCNT(b.x)], 1u);
    return b;
}
__device__ __forceinline__ void xcd_barrier_complete(unsigned* bar, unsigned x, unsigned& nloc, unsigned& nx) {
    const unsigned G = gridDim.x * gridDim.y * gridDim.z;
    unsigned sum, cnt, mine, sp = 0u;
    for (;;) {
        sum = 0u; cnt = 0u; mine = 0u;
#pragma unroll
        for (unsigned j = 0; j < 16; ++j) { const unsigned c = xb_ld(&bar[XB_XCNT(j)]); sum += c; cnt += (c > 0u) ? 1u : 0u; mine = (j == x) ? c : mine; }
        if (sum == G) break;
        __builtin_amdgcn_s_sleep(1);
        if ((++sp & 255u) == 0u) { if (xb_ld(&bar[XB_TMO])) break; if (sp > XB_SPIN_CAP) { atomicAdd(&bar[XB_TMO], 1u); break; } }
    }
    nloc = mine > 0u ? mine : 1u; nx = cnt > 0u ? cnt : 1u;
}

__device__ __forceinline__ void xcd_barrier(const XcdBarrier& b) {
    asm volatile("s_waitcnt vmcnt(0)" ::: "memory");
    __syncthreads();
    if (threadIdx.x == 0) {
        unsigned* bar = b.bar;
        __builtin_amdgcn_s_waitcnt(0);
        unsigned nloc = b.st[0], nx = b.st[1];
        if (nloc == 0u) { xcd_barrier_complete(bar, b.x, nloc, nx); b.st[0] = nloc; b.st[1] = nx; }
        const unsigned old = xb_add(&bar[XB_XSUB(b.x)], 1u);
        const unsigned gen = old / nloc;
        if (old + 1u == (gen + 1u) * nloc) {
            __builtin_amdgcn_fence(__ATOMIC_RELEASE, "agent");
            asm volatile("s_waitcnt vmcnt(0)" ::: "memory");
            const unsigned og = xb_add(&bar[XB_TOP], 1u);
            const unsigned tg = og / nx;
            if (og + 1u == (tg + 1u) * nx) xb_add(&bar[XB_TOPGEN], 1u);
            else XB_SPIN(xb_ld(&bar[XB_TOPGEN]) == tg, bar);
            __builtin_amdgcn_fence(__ATOMIC_ACQUIRE, "agent");
            xb_add(&bar[XB_XGEN(b.x)], 1u);
            asm volatile("s_waitcnt vmcnt(0)" ::: "memory");
        } else {
            XB_SPIN(xb_ld(&bar[XB_XGEN(b.x)]) == gen, bar);
            __builtin_amdgcn_fence(__ATOMIC_ACQUIRE, "agent");
            asm volatile("s_waitcnt vmcnt(0)" ::: "memory");
        }
    }
    __syncthreads();
}

__device__ __forceinline__ void xcd_barrier_fast(const XcdBarrier& b) {
    asm volatile("s_waitcnt vmcnt(0)" ::: "memory");
    __syncthreads();
    if (threadIdx.x == 0) {
        unsigned* bar = b.bar;
        __builtin_amdgcn_s_waitcnt(0);
        unsigned nloc = b.st[0], nx = b.st[1];
        const unsigned old = xb_add(&bar[XB_XSUB(b.x)], 1u);
        const unsigned gen = old / nloc;
        if (old + 1u == (gen + 1u) * nloc) {
            __builtin_amdgcn_fence(__ATOMIC_RELEASE, "agent");
            asm volatile("s_waitcnt vmcnt(0)" ::: "memory");
            const unsigned og = xb_add(&bar[XB_TOP], 1u);
            const unsigned tg = og / nx;
            if (og + 1u == (tg + 1u) * nx) xb_add(&bar[XB_TOPGEN], 1u);
            else XB_SPIN(xb_ld(&bar[XB_TOPGEN]) == tg, bar);
            __builtin_amdgcn_fence(__ATOMIC_ACQUIRE, "agent");
            xb_add(&bar[XB_XGEN(b.x)], 1u);
            asm volatile("s_waitcnt vmcnt(0)" ::: "memory");
        } else {
            XB_SPIN(xb_ld(&bar[XB_XGEN(b.x)]) == gen, bar);
            __builtin_amdgcn_fence(__ATOMIC_ACQUIRE, "agent");
            asm volatile("s_waitcnt vmcnt(0)" ::: "memory");
        }
    }
    __syncthreads();
}

__global__ void __launch_bounds__(512, 2) mega_fwd(Params P) {
    extern __shared__ __attribute__((aligned(16))) unsigned char lds_raw[];
    cg::grid_group grid = cg::this_grid();
    LAS unsigned char* lds = (LAS unsigned char*)lds_raw;
    volatile LAS unsigned* bst = (volatile LAS unsigned*)(lds + 156144);
    if (threadIdx.x < 2) bst[threadIdx.x] = 0u;
    __syncthreads();
    (void)xcd_barrier_post((unsigned*)P.ws, bst);
#define GRID_BAR() do { XcdBarrier b_; b_.bar = (unsigned*)P.ws; b_.x = xb_xcc_id(); b_.st = (volatile LAS unsigned*)(lds + 156144); xcd_barrier_fast(b_); } while (0)
#define PHASE_IDS() int tid_ = threadIdx.x; asm volatile("" : "+v"(tid_)); const int tid = tid_, lane = tid & 63, wave = __builtin_amdgcn_readfirstlane(tid >> 6); \
    int G_ = gridDim.x, blk_ = blockIdx.x; asm volatile("" : "+s"(G_), "+s"(blk_)); const int G = G_, blk = blk_, gw = blk * 8 + wave, NGW = G * 8; \
    const size_t gtid = (size_t)blk * 512 + tid, GT = (size_t)G * 512; (void)lane; (void)gw; (void)NGW; (void)gtid; (void)GT; \
    unsigned char* ws = P.ws; float* X = P.out; asm volatile("" : "+s"(ws), "+s"(X)); \
    f32x2* ROPE_DA = (f32x2*)(ws + WS_ROPE_DA); f32x2* ROPE_RET = (f32x2*)(ws + WS_ROPE_RET); \
    bf16_t* W = (bf16_t*)(ws + WS_W); bf16_t* MEMB = (bf16_t*)(ws + WS_MEMB); bf16_t* XB = (bf16_t*)(ws + WS_XB); \
    bf16_t* BIG = (bf16_t*)(ws + WS_BIG); bf16_t* CAT = (bf16_t*)(ws + WS_CAT); \
    unsigned* AB = (unsigned*)(ws + WS_AUX); bf16_t* XC = (bf16_t*)(ws + WS_AUX2); bf16_t* Z5 = (bf16_t*)(ws + WS_AUX); bf16_t* KV = (bf16_t*)(ws + WS_AUX); \
    (void)X; (void)ROPE_DA; (void)ROPE_RET; (void)W; (void)MEMB; (void)XB; (void)BIG; (void)CAT; (void)AB; (void)XC; (void)Z5; (void)KV; \
    int l = lcur; asm volatile("" : "+s"(l)); const bf16_t* Wl = W + (size_t)l * LAYER_W; const int hl = l >> 1; bf16_t* Z = BIG; (void)Wl; (void)hl; (void)Z;
#define LN_CTX() const int kcur = l * 4 + si_; float* Scur = (float*)(ws + WS_STATS) + (size_t)(kcur & 1) * 524288; float* Snxt = (float*)(ws + WS_STATS) + (size_t)((kcur + 1) & 1) * 524288; \
    const float* cvk = (const float*)(ws + WS_CVEC) + (size_t)kcur * CVEC_STRIDE; (void)Scur; (void)Snxt; (void)cvk;
#define ZERO_SNXT()
    int lcur = 0;

    {
        PHASE_IDS();
        LAS float* scr = (LAS float*)(lds + wave * 16384);
        int base_item = 0;
        for (int l = 0; l < 4; ++l) {
            bf16_t* Wl = W + (size_t)l * LAYER_W;
            for (int s = 0; s < 2; ++s) {
                const size_t wi = (size_t)(l * 2 + s) * 1024 * 2816;
                const int kq = l * 4 + (s ? 3 : 0);
                const float* gs1 = kq ? P.in[2] + (size_t)(kq - 1) * 1024 : nullptr;
                transpose_mat(P.in[4] + wi, 1024, 2816, Wl + OFF_W1 + s * SZ_W1, 1, 0, scr, gw, NGW, lane, base_item, gs1);
                transpose_mat(P.in[5] + wi, 1024, 2816, Wl + OFF_W1 + s * SZ_W1, 1, 128, scr, gw, NGW, lane, base_item, gs1);
                transpose_mat(P.in[6] + wi, 2816, 1024, Wl + OFF_W2 + s * SZ_W2, 0, 0, scr, gw, NGW, lane, base_item);
            }
            transpose_mat(P.in[7] + (size_t)l * 1048576, 1024, 1024, Wl + OFF_WQ, 0, 0, scr, gw, NGW, lane, base_item, P.in[2] + (size_t)(l * 4 + 1) * 1024);
            transpose_mat(P.in[8] + (size_t)l * 2097152, 1024, 2048, Wl + OFF_WKV, 0, 0, scr, gw, NGW, lane, base_item);
            transpose_mat(P.in[9] + (size_t)l * 1048576, 1024, 1024, Wl + OFF_WO, 0, 0, scr, gw, NGW, lane, base_item);
            const int h = l >> 1;
            if (l & 1) transpose_mat(P.in[19] + (size_t)h * 2097152, 1024, 2048, Wl + OFF_WIN, 0, 0, scr, gw, NGW, lane, base_item, P.in[2] + (size_t)(l * 4) * 1024);
            else transpose_mat(P.in[10] + (size_t)h * 2621440, 1024, 2560, Wl + OFF_WIN, 0, 0, scr, gw, NGW, lane, base_item, P.in[2] + (size_t)(l * 4) * 1024);
            transpose_mat(((l & 1) ? P.in[20] : P.in[11]) + (size_t)h * 1048576, 1024, 1024, Wl + OFF_WOUT, 0, 0, scr, gw, NGW, lane, base_item);
            if (l & 1) transpose_mat(P.in[29] + (size_t)h * 262144, 512, 512, Wl + OFF_WEX, 0, 0, scr, gw, NGW, lane, base_item);
            else {
                const float* gwt = P.in[16] + (size_t)h * 2 * 8 * 64 * 64;
                bf16_t* dst = Wl + OFF_WEX;
                for (size_t i = gtid; i < (size_t)1024 * 512; i += GT) { const int row = (int)(i >> 9), k = (int)(i & 511);
                    const int pn = row >> 8, gsel = (row >> 7) & 1, ch = pn * 128 + (row & 127);
                    float v = 0.f; if ((k >> 6) == (ch >> 6)) v = gwt[(((size_t)gsel * 8 + (ch >> 6)) * 64 + (k & 63)) * 64 + (ch & 63)];
                    dst[i] = f2bf(v); }
            }
        }
        for (size_t wv_ = gtid >> 6; wv_ * 32 < (size_t)4 * 14848; wv_ += GT >> 6) {
            const size_t idx = wv_ * 32 + (lane & 31); const int kseg = (lane >> 5) * 512;
            const int l = (int)(idx / 14848); int rem = (int)(idx % 14848); const int h = l >> 1;
            int k; const float* Wp; int N, n, drow;
            if (rem < 5632) { k = l * 4; const int half = rem / 2816; n = rem % 2816; Wp = (half ? P.in[5] : P.in[4]) + (size_t)(l * 2) * 1024 * 2816; N = 2816; drow = (n >> 7) * 256 + half * 128 + (n & 127); }
            else if (rem < 8192) { rem -= 5632; k = l * 4 + 1; n = rem; N = (l & 1) ? 2048 : 2560; Wp = (l & 1) ? P.in[19] + (size_t)h * 2097152 : P.in[10] + (size_t)h * 2621440; drow = n; }
            else if (rem < 9216) { rem -= 8192; k = l * 4 + 2; n = rem; N = 1024; Wp = P.in[7] + (size_t)l * 1048576; drow = n; }
            else { rem -= 9216; k = l * 4 + 3; const int half = rem / 2816; n = rem % 2816; Wp = (half ? P.in[5] : P.in[4]) + (size_t)(l * 2 + 1) * 1024 * 2816; N = 2816; drow = (n >> 7) * 256 + half * 128 + (n & 127); }
            if (n < N) {
                float s1 = 0.f, s2 = 0.f;
                if (k == 0) {
#pragma unroll 16
                    for (int kk = kseg; kk < kseg + 512; ++kk) s1 += Wp[(size_t)kk * N + n];
                } else {
                    const float* gq = P.in[2] + (size_t)(k - 1) * 1024; const float* bq = P.in[3] + (size_t)(k - 1) * 1024;
#pragma unroll 16
                    for (int kk = kseg; kk < kseg + 512; ++kk) { const float wv = Wp[(size_t)kk * N + n]; s1 += gq[kk] * wv; s2 += bq[kk] * wv; }
                }
                s1 = xsum32(s1); s2 = xsum32(s2);
                if (kseg == 0) { float* cv = (float*)(ws + WS_CVEC) + (size_t)k * CVEC_STRIDE; cv[drow] = s1; cv[5632 + drow] = s2; }
            }
        }
        for (size_t i = gtid; i < 1024; i += GT) { ((float*)(ws + WS_ONES))[i] = 1.0f; ((float*)(ws + WS_ZEROS))[i] = 0.0f; }
        for (size_t i = gtid; i < (size_t)T_TOK * 4; i += GT) { ((f32x2*)(ws + WS_STATS))[i] = (f32x2){0.f, (i & 3) ? 0.f : 1024.0f * (1.0f - 1e-5f)}; }
        for (size_t i = gtid; i < 1024; i += GT) { const float L = P.in[18][i]; ((float*)(ws + WS_SPL))[i] = -8.0f * (fmaxf(-L, 0.f) + log1pf(expf(-fabsf(L)))); }
        for (size_t i0 = gtid; i0 < (size_t)MEMT * DM / 4; i0 += GT * 4) {
            f32x4 vv[4];
#pragma unroll
            for (int q = 0; q < 4; ++q) { const size_t i = i0 + (size_t)q * GT; vv[q] = (i < (size_t)MEMT * DM / 4) ? ((const f32x4*)P.in[1])[i] : (f32x4){0.f, 0.f, 0.f, 0.f}; }
#pragma unroll
            for (int q = 0; q < 4; ++q) { const size_t i = i0 + (size_t)q * GT; if (i < (size_t)MEMT * DM / 4) { const f32x4 v = vv[q];
                ((unsigned long long*)MEMB)[i] = (unsigned long long)cvt_pk_bf16(v[0], v[1]) | ((unsigned long long)cvt_pk_bf16(v[2], v[3]) << 32); } }
        }
        for (size_t i0 = gtid; i0 < (size_t)T_TOK * DM / 4; i0 += GT * 8) {
            f32x4 vv[8];
#pragma unroll
            for (int q = 0; q < 8; ++q) { const size_t i = i0 + (size_t)q * GT; vv[q] = (i < (size_t)T_TOK * DM / 4) ? ((const f32x4*)P.in[0])[i] : (f32x4){0.f, 0.f, 0.f, 0.f}; }
#pragma unroll
            for (int q = 0; q < 8; ++q) { const size_t i = i0 + (size_t)q * GT; if (i < (size_t)T_TOK * DM / 4) { const f32x4 v = vv[q];
                const unsigned h0 = cvt_pk_bf16(v[0], v[1]), h1 = cvt_pk_bf16(v[2], v[3]);
                const unsigned l0 = cvt_pk_bf16(v[0] - bflo(h0), v[1] - bfhi(h0)), l1 = cvt_pk_bf16(v[2] - bflo(h1), v[3] - bfhi(h1));
                ((unsigned long long*)XB)[i] = (unsigned long long)h0 | ((unsigned long long)h1 << 32);
                const size_t row = i >> 8, c4 = i & 255;
                ((unsigned long long*)X)[row * 512 + 256 + c4] = (unsigned long long)l0 | ((unsigned long long)l1 << 32); } }
        }
        for (size_t i = gtid; i < (size_t)SEQ * 40; i += GT) { const int pos = (int)(i / 40), e = (int)(i % 40);
            float inv; if (e < 8) inv = (float)exp2(-((double)e * 2.0 / 16.0) * 18.931568569324174);
            else inv = (float)exp2(-((double)(e - 8) * 2.0 / 64.0) * 13.287712379549449);
            const float ang = (float)pos * inv; float s, c; sincos_acc(ang, s, c);
            if (e < 8) ROPE_DA[pos * 8 + e] = (f32x2){c, s}; else ROPE_RET[pos * 32 + (e - 8)] = (f32x2){c, s}; }
    }
    __syncthreads();
    grid.sync();
    { XcdBarrier b_; b_.bar = (unsigned*)P.ws; b_.x = xb_xcc_id(); b_.st = (volatile LAS unsigned*)(lds + 156144); xcd_barrier(b_); }

    for (lcur = 0; lcur < 4; ++lcur) {
        const bool odd = (lcur & 1) != 0;
        for (int si = 0; si < 4; ++si) {
            int asel; size_t boff; int Kres; float sres;
            if (si == 0 || si == 3) {
                const int s = (si == 0) ? 0 : 1;
                { PHASE_IDS(); int si_ = si; asm volatile("" : "+s"(si_)); LN_CTX(); ZERO_SNXT(); pg8::Gemm g{XB, Wl + OFF_W1 + s * SZ_W1, T_TOK, 5632, 1024}; pg8::StaticOrder S; S.init(T_TOK, 5632, G, blk);
                  { LAS unsigned* CV = (LAS unsigned*)(lds + 131072); for (int i = tid; i < 5632; i += 512) CV[i] = (cvt_pk_bf16(cvk[i], 0.f) & 0xffffu) | (cvt_pk_bf16(cvk[5632 + i], 0.f) << 16);
                    if (tid < 2) ((volatile LAS int*)(lds + 155648))[tid] = -1; __syncthreads(); }
                  pg8::EpiSwiglu E{BIG, DFF, pg8::LnFix{Scur, cvk, cvk + 5632}}; pg8::gemm_phase<pg8::EpiSwiglu, pg8::StaticOrder, true, true>(lds, g, S, E); }
                GRID_BAR();
                asel = 0; boff = OFF_W2 + s * SZ_W2; Kres = DFF; sres = 0.5f;
            } else if (si == 1) {
                { PHASE_IDS(); int si_ = si; asm volatile("" : "+s"(si_)); LN_CTX(); ZERO_SNXT(); const int nin = odd ? 2048 : 2560; pg8::Gemm g{XB, Wl + OFF_WIN, T_TOK, nin, 1024}; pg8::StaticOrder S; S.init(T_TOK, nin, G, blk);
                  { LAS unsigned* CV = (LAS unsigned*)(lds + 131072); for (int i = tid; i < nin; i += 512) CV[i] = (cvt_pk_bf16(cvk[i], 0.f) & 0xffffu) | (cvt_pk_bf16(cvk[5632 + i], 0.f) << 16);
                    if (tid < 2) ((volatile LAS int*)(lds + 155648))[tid] = -1; __syncthreads(); }
                  pg8::EpiStore E{BIG, ZW, pg8::LnFix{Scur, cvk, cvk + 5632}}; pg8::gemm_phase<pg8::EpiStore, pg8::StaticOrder, true, true>(lds, g, S, E); }
                GRID_BAR();
                if (!odd) {
                    { PHASE_IDS();
                    for (size_t idx0 = gtid; idx0 < (size_t)T_TOK * 16; idx0 += GT * 4) {
                        u32x4 av[4], bv4[4]; f32x4 tv[4][4];
#pragma unroll
                        for (int q = 0; q < 4; ++q) { const size_t idx = idx0 + (size_t)q * GT; const bool ok = idx < (size_t)T_TOK * 16; const size_t ix = ok ? idx : 0;
                            const int row = (int)(ix >> 4), sub = (int)(ix & 15), qk = sub >> 3, hm = sub & 7, pos = row & (SEQ - 1);
                            const bf16_t* p = Z + (size_t)row * ZW + qk * 512 + hm * 64; av[q] = *(const u32x4*)p; bv4[q] = *(const u32x4*)(p + 8);
#pragma unroll
                            for (int e = 0; e < 4; ++e) tv[q][e] = ((const f32x4*)(ROPE_DA + pos * 8))[e]; }
#pragma unroll
                        for (int q = 0; q < 4; ++q) { const size_t idx = idx0 + (size_t)q * GT; if (idx < (size_t)T_TOK * 16) {
                            const int row = (int)(idx >> 4), sub = (int)(idx & 15), qk = sub >> 3, hm = sub & 7;
                            bf16_t* p = Z + (size_t)row * ZW + qk * 512 + hm * 64; float o1[8], o2[8];
#pragma unroll
                            for (int e = 0; e < 8; ++e) { const unsigned wa = av[q][e >> 1], wb = bv4[q][e >> 1]; const float x1 = (e & 1) ? bfhi(wa) : bflo(wa), x2 = (e & 1) ? bfhi(wb) : bflo(wb);
                                const float cs_ = tv[q][e >> 1][(e & 1) * 2], sn_ = tv[q][e >> 1][(e & 1) * 2 + 1]; o1[e] = x1 * cs_ - x2 * sn_; o2[e] = x1 * sn_ + x2 * cs_; }
                            u32x4 wa, wb; wa.x = cvt_pk_bf16(o1[0], o1[1]); wa.y = cvt_pk_bf16(o1[2], o1[3]); wa.z = cvt_pk_bf16(o1[4], o1[5]); wa.w = cvt_pk_bf16(o1[6], o1[7]);
                            wb.x = cvt_pk_bf16(o2[0], o2[1]); wb.y = cvt_pk_bf16(o2[2], o2[3]); wb.z = cvt_pk_bf16(o2[4], o2[5]); wb.w = cvt_pk_bf16(o2[6], o2[7]);
                            *(u32x4*)p = wa; *(u32x4*)(p + 8) = wb; } }
                    }
                    { const float* cw = P.in[14] + (size_t)hl * 4 * 512; const float* cbs = P.in[15] + (size_t)hl * 512;
                      const int c0 = (int)(gtid & 63) * 8;
                      f32x4 wv[4][2], bb[2];
#pragma unroll
                      for (int j = 0; j < 4; ++j) { wv[j][0] = *(const f32x4*)(cw + j * 512 + c0); wv[j][1] = *(const f32x4*)(cw + j * 512 + c0 + 4); }
                      bb[0] = *(const f32x4*)(cbs + c0); bb[1] = *(const f32x4*)(cbs + c0 + 4);
                      for (size_t idx0 = gtid; idx0 < (size_t)T_TOK * 64; idx0 += GT * 4) {
                        u32x4 xv[4][4];
#pragma unroll
                        for (int q = 0; q < 4; ++q) { const size_t idx = idx0 + (size_t)q * GT; const bool ok = idx < (size_t)T_TOK * 64; const int row = ok ? (int)(idx >> 6) : 3, pos = row & (SEQ - 1);
#pragma unroll
                            for (int j = 0; j < 4; ++j) xv[q][j] = (pos - 3 + j >= 0) ? *(const u32x4*)(Z + (size_t)(row - 3 + j) * ZW + 2048 + c0) : (u32x4){0u, 0u, 0u, 0u}; }
#pragma unroll
                        for (int q = 0; q < 4; ++q) { const size_t idx = idx0 + (size_t)q * GT; if (idx < (size_t)T_TOK * 64) { const int row = (int)(idx >> 6);
                            f32x4 a0 = bb[0], a1 = bb[1];
#pragma unroll
                            for (int j = 0; j < 4; ++j) { const u32x4 v = xv[q][j]; f32x4 x0, x1; x0[0] = bflo(v.x); x0[1] = bfhi(v.x); x0[2] = bflo(v.y); x0[3] = bfhi(v.y); x1[0] = bflo(v.z); x1[1] = bfhi(v.z); x1[2] = bflo(v.w); x1[3] = bfhi(v.w);
                                a0 += wv[j][0] * x0; a1 += wv[j][1] * x1; }
                            u32x4 o; o.x = cvt_pk_bf16(a0[0], a0[1]); o.y = cvt_pk_bf16(a0[2], a0[3]); o.z = cvt_pk_bf16(a1[0], a1[1]); o.w = cvt_pk_bf16(a1[2], a1[3]);
                            *(u32x4*)(XC + (size_t)row * 512 + c0) = o; } }
                      } }
                    }
                    GRID_BAR();
                    { PHASE_IDS(); pg8::Gemm g{XC, Wl + OFF_WEX, T_TOK, 1024, 512}; pg8::StaticOrder S; S.init(T_TOK, 1024, G, blk);
                      pg8::EpiLru E{AB, XC, P.in[17] + (size_t)hl * 1024, (const float*)(ws + WS_SPL) + (size_t)hl * 512};
                      pg8::gemm_phase<pg8::EpiLru, pg8::StaticOrder, true, true>(lds, g, S, E); }
                    GRID_BAR();
                    { PHASE_IDS();
                        const float* lamp = P.in[12] + (size_t)hl * 256; const float* ng = P.in[13] + (size_t)hl * 128;
                        float d1 = lamp[lane] * lamp[64 + lane], d2 = lamp[128 + lane] * lamp[192 + lane]; d1 = wave_sum(d1); d2 = wave_sum(d2);
                        const float lam_init = 0.8f - 0.6f * expf(-0.3f * (float)l);
                        const float lmb = expf(d1) - expf(d2) + lam_init;
                        const int r = lane & 15, g4 = lane >> 4;
                        for (int u = blk; u < 2048; u += G) {
                            const int bh = u & 127, b = bh >> 2, h = bh & 3, qi_ = u >> 7, ii_ = qi_ >> 1, hb_ = qi_ & 1, qt = (ii_ & 1) ? (ii_ - 1 + hb_) : (15 - hb_ - ii_), q0 = qt * 128, nkt = (q0 + 128) / 64;
                            const size_t rb = (size_t)b * SEQ;
                            f32x4 o[2][8]; float ll[2];
                            attn_core3<64, 128, 1, 2, 64>(lds, Z + (rb + q0) * ZW + h * 128, ZW, Z + rb * ZW + 512 + h * 128, ZW, Z + rb * ZW + 1024 + h * 128, ZW, q0, nkt, 0.125f * LOG2E, 0.f, o, ll);
                            const float iv0 = 1.0f / ll[0], f1 = lmb / ll[1]; float ss = 0.f;
#pragma unroll
                            for (int cb = 0; cb < 8; ++cb)
#pragma unroll
                                for (int j = 0; j < 4; ++j) { const float v = o[0][cb][j] * iv0 - f1 * o[1][cb][j]; o[0][cb][j] = v; ss += v * v; }
                            ss = xsum_rows(ss);
                            const float rs = rsqrtf(ss * (1.0f / 128.0f) + LN_EPS) * (1.0f - lam_init);
                            const size_t row = rb + q0 + wave * 16 + r;
                            f32x4 ggv[8];
#pragma unroll
                            for (int cb = 0; cb < 8; ++cb) ggv[cb] = *(const f32x4*)(ng + cb * 16 + g4 * 4);
#pragma unroll
                            for (int cb = 0; cb < 8; ++cb) { const f32x4 gg = ggv[cb]; const f32x4 v = o[0][cb] * rs * gg;
                                u32x2 wv; wv.x = cvt_pk_bf16(v[0], v[1]); wv.y = cvt_pk_bf16(v[2], v[3]); *(u32x2*)(CAT + row * 1024 + h * 128 + cb * 16 + g4 * 4) = wv; }
                        }
                    }
                    { PHASE_IDS();
                        LAS float* sA = (LAS float*)lds; LAS float* sB = sA + 32 * 64;
                        for (int u = blk; u < 256; u += G) {
                            const int b = u >> 3, cgp = u & 7, jc = tid >> 4, q = tid & 15, ch0 = cgp * 64 + q * 4;
                            const size_t row0 = (size_t)b * SEQ + jc * 64;
                            const unsigned* ab = AB + row0 * 512 + ch0;
                            float h[4] = {0.f, 0.f, 0.f, 0.f}, sl[4] = {0.f, 0.f, 0.f, 0.f};
                            for (int t0 = 0; t0 < 64; t0 += 16) {
                                u32x4 wv[16];
#pragma unroll
                                for (int i = 0; i < 16; ++i) wv[i] = *(const u32x4*)(ab + (size_t)(t0 + i) * 512);
#pragma unroll
                                for (int i = 0; i < 16; ++i)
#pragma unroll
                                    for (int k = 0; k < 4; ++k) { const float la = bflo(wv[i][k]), bb = bfhi(wv[i][k]); h[k] = __builtin_amdgcn_exp2f(la) * h[k] + bb; sl[k] += la; }
                            }
                            __syncthreads();
                            *(LAS f32x4*)(sA + jc * 64 + q * 4) = (f32x4){sl[0], sl[1], sl[2], sl[3]}; *(LAS f32x4*)(sB + jc * 64 + q * 4) = (f32x4){h[0], h[1], h[2], h[3]};
                            __syncthreads();
                            float hin[4] = {0.f, 0.f, 0.f, 0.f};
#pragma unroll 8
                            for (int jj = 0; jj < 31; ++jj) { const f32x4 a4 = *(const LAS f32x4*)(sA + jj * 64 + q * 4), b4 = *(const LAS f32x4*)(sB + jj * 64 + q * 4); const bool on = jj < jc;
#pragma unroll
                                for (int k = 0; k < 4; ++k) { const float av = on ? __builtin_amdgcn_exp2f(a4[k]) : 1.0f, bv_ = on ? b4[k] : 0.0f; hin[k] = av * hin[k] + bv_; } }
#pragma unroll
                            for (int k = 0; k < 4; ++k) h[k] = hin[k];
                            const bf16_t* gp = Z + row0 * ZW + 1536 + ch0; bf16_t* op = CAT + row0 * 1024 + 512 + ch0;
                            for (int t0 = 0; t0 < 64; t0 += 16) {
                                u32x4 wv[16]; u32x2 gv2[16];
#pragma unroll
                                for (int i = 0; i < 16; ++i) { wv[i] = *(const u32x4*)(ab + (size_t)(t0 + i) * 512); gv2[i] = *(const u32x2*)(gp + (size_t)(t0 + i) * ZW); }
#pragma unroll
                                for (int i = 0; i < 16; ++i) { float o4[4];
#pragma unroll
                                    for (int k = 0; k < 4; ++k) { const float la = bflo(wv[i][k]), bb = bfhi(wv[i][k]); h[k] = __builtin_amdgcn_exp2f(la) * h[k] + bb;
                                        const unsigned gw = gv2[i][k >> 1]; const float gt = (k & 1) ? bfhi(gw) : bflo(gw); o4[k] = gelu_tanh(gt) * h[k]; }
                                    u32x2 ow; ow.x = cvt_pk_bf16(o4[0], o4[1]); ow.y = cvt_pk_bf16(o4[2], o4[3]); *(u32x2*)(op + (size_t)(t0 + i) * 1024) = ow; }
                            }
                        }
                    }
                    __syncthreads();
                    GRID_BAR();
                } else {
                    { PHASE_IDS();
                    for (size_t idx0 = gtid; idx0 < (size_t)T_TOK * 32; idx0 += GT * 4) {
                        u32x4 av[4], bv4[4]; f32x4 tv[4][4];
#pragma unroll
                        for (int q = 0; q < 4; ++q) { const size_t idx = idx0 + (size_t)q * GT; const bool ok = idx < (size_t)T_TOK * 32; const size_t ix = ok ? idx : 0;
                            const int row = (int)(ix >> 5), sub = (int)(ix & 31), qk = sub >> 4, h = (sub >> 2) & 3, c = sub & 3, pos = row & (SEQ - 1);
                            const bf16_t* p = Z + (size_t)row * ZW + 512 + qk * 256 + h * 64 + c * 8; av[q] = *(const u32x4*)p; bv4[q] = *(const u32x4*)(p + 32);
#pragma unroll
                            for (int e = 0; e < 4; ++e) tv[q][e] = ((const f32x4*)(ROPE_RET + pos * 32 + c * 8))[e]; }
#pragma unroll
                        for (int q = 0; q < 4; ++q) { const size_t idx = idx0 + (size_t)q * GT; if (idx < (size_t)T_TOK * 32) {
                            const int row = (int)(idx >> 5), sub = (int)(idx & 31), qk = sub >> 4, h = (sub >> 2) & 3, c = sub & 3;
                            bf16_t* p = Z + (size_t)row * ZW + 512 + qk * 256 + h * 64 + c * 8; const float ksc = qk ? 0.125f : 1.0f; float o1[8], o2[8];
#pragma unroll
                            for (int e = 0; e < 8; ++e) { const unsigned wa = av[q][e >> 1], wb = bv4[q][e >> 1]; const float x1 = (e & 1) ? bfhi(wa) : bflo(wa), x2 = (e & 1) ? bfhi(wb) : bflo(wb);
                                const float cs_ = tv[q][e >> 1][(e & 1) * 2], sn_ = tv[q][e >> 1][(e & 1) * 2 + 1]; o1[e] = (x1 * cs_ - x2 * sn_) * ksc; o2[e] = (x1 * sn_ + x2 * cs_) * ksc; }
                            u32x4 wa, wb; wa.x = cvt_pk_bf16(o1[0], o1[1]); wa.y = cvt_pk_bf16(o1[2], o1[3]); wa.z = cvt_pk_bf16(o1[4], o1[5]); wa.w = cvt_pk_bf16(o1[6], o1[7]);
                            wb.x = cvt_pk_bf16(o2[0], o2[1]); wb.y = cvt_pk_bf16(o2[2], o2[3]); wb.z = cvt_pk_bf16(o2[4], o2[5]); wb.w = cvt_pk_bf16(o2[6], o2[7]);
                            *(u32x4*)p = wa; *(u32x4*)(p + 32) = wb; } }
                    }
                    }
                    __syncthreads();
                    { PHASE_IDS();
                    if (wave < 4) {
                        for (int u = blk * 4 + wave; u < 1024; u += G * 4)
                            s5_unit(lds + wave * S5_LDS_WAVE, u >> 5, u & 31, P.in[21] + (size_t)hl * 2048, P.in[22] + (size_t)hl * 2048, P.in[23] + (size_t)hl * 32,
                                    P.in[24] + (size_t)hl * 32768, P.in[25] + (size_t)hl * 32768, P.in[26] + (size_t)hl * 32768, P.in[27] + (size_t)hl * 32768,
                                    P.in[28] + (size_t)hl * 512, Z, Z5, lane);
                    }
                    }
                    __syncthreads();
                    GRID_BAR();
                    { PHASE_IDS();
                        const float* rg = P.in[31] + (size_t)hl * 128;
                        const int r = lane & 15, g4 = lane >> 4;
                        for (int u = blk; u < 2048; u += G) {
                            const int bh = u & 127, b = bh >> 2, h = bh & 3, qi_ = u >> 7, ii_ = qi_ >> 1, hb_ = qi_ & 1, qt = (ii_ & 1) ? (ii_ - 1 + hb_) : (15 - hb_ - ii_), q0 = qt * 128, nkt = qt + 1;
                            const size_t rb = (size_t)b * SEQ;
                            const float l2g = log2f(1.0f - exp2f(-5.0f - (float)h));
                            f32x4 o[1][8]; float ll[1];
                            attn_core3<64, 128, 2, 1, 128>(lds, Z + (rb + q0) * ZW + 512 + h * 64, ZW, Z + rb * ZW + 768 + h * 64, ZW, Z + rb * ZW + 1024 + h * 128, ZW, q0, nkt, 1.0f, l2g, o, ll);
                            float sm = 0.f;
#pragma unroll
                            for (int cb = 0; cb < 8; ++cb) sm += (o[0][cb][0] + o[0][cb][1]) + (o[0][cb][2] + o[0][cb][3]);
                            sm = xsum_rows(sm);
                            const float mean = sm * (1.0f / 128.0f); float sq = 0.f;
#pragma unroll
                            for (int cb = 0; cb < 8; ++cb) { o[0][cb] = o[0][cb] - mean; sq += (o[0][cb][0] * o[0][cb][0] + o[0][cb][1] * o[0][cb][1]) + (o[0][cb][2] * o[0][cb][2] + o[0][cb][3] * o[0][cb][3]); }
                            sq = xsum_rows(sq);
                            const float rstd = rsqrtf(sq * (1.0f / 128.0f) + LN_EPS);
                            const size_t row = rb + q0 + wave * 16 + r;
                            f32x4 ggv[8]; u32x2 gwv[8];
#pragma unroll
                            for (int cb = 0; cb < 8; ++cb) { const int col = cb * 16 + g4 * 4; ggv[cb] = *(const f32x4*)(rg + col); gwv[cb] = *(const u32x2*)(Z + row * ZW + 1536 + h * 128 + col); }
#pragma unroll
                            for (int cb = 0; cb < 8; ++cb) { const int col = cb * 16 + g4 * 4; const f32x4 gg = ggv[cb];
                                const u32x2 gw = gwv[cb];
                                f32x4 gt; gt[0] = bflo(gw.x); gt[1] = bfhi(gw.x); gt[2] = bflo(gw.y); gt[3] = bfhi(gw.y);
                                f32x4 v;
#pragma unroll
                                for (int j = 0; j < 4; ++j) v[j] = silu_f(gt[j]) * o[0][cb][j] * rstd * gg[j];
                                u32x2 wv; wv.x = cvt_pk_bf16(v[0], v[1]); wv.y = cvt_pk_bf16(v[2], v[3]); *(u32x2*)(CAT + row * 1024 + 512 + h * 128 + col) = wv; }
                        }
                    }
                    __syncthreads();
                    { PHASE_IDS(); pg8::Gemm g{Z5, Wl + OFF_WEX, T_TOK, 512, 512}; pg8::StaticOrder S; S.init(T_TOK, 512, G, blk);
                      pg8::EpiGlu E{CAT, 1024, Z5, P.in[30] + (size_t)hl * 512};
                      pg8::gemm_phase<pg8::EpiGlu, pg8::StaticOrder, true, true>(lds, g, S, E); }
                    GRID_BAR();
                }
                asel = 1; boff = OFF_WOUT; Kres = 1024; sres = 1.0f;
            } else {
                { PHASE_IDS(); int si_ = si; asm volatile("" : "+s"(si_)); LN_CTX(); ZERO_SNXT(); pg8::Gemm g{XB, Wl + OFF_WQ, T_TOK, 1024, 1024}; pg8::StaticOrder S; S.init(T_TOK, 1024, G, blk);
                  { LAS unsigned* CV = (LAS unsigned*)(lds + 131072); for (int i = tid; i < 1024; i += 512) CV[i] = (cvt_pk_bf16(cvk[i], 0.f) & 0xffffu) | (cvt_pk_bf16(cvk[5632 + i], 0.f) << 16);
                    if (tid < 2) ((volatile LAS int*)(lds + 155648))[tid] = -1; __syncthreads(); }
                  pg8::EpiStore E{BIG, 1024, pg8::LnFix{Scur, cvk, cvk + 5632}}; pg8::gemm_phase<pg8::EpiStore, pg8::StaticOrder, true, true>(lds, g, S, E); }
                { PHASE_IDS(); pg8::Gemm g{MEMB, Wl + OFF_WKV, MEMT, 2048, 1024}; pg8::StaticOrder S; S.init(MEMT, 2048, G, blk);
                  pg8::EpiStore E{KV, 2048, pg8::LnFix{nullptr, nullptr, nullptr}}; pg8::gemm_phase<pg8::EpiStore, pg8::StaticOrder, true, true>(lds, g, S, E); }
                GRID_BAR();
                { PHASE_IDS();
                    const int r = lane & 15, g4 = lane >> 4;
                    for (int u = blk; u < 2048; u += G) {
                        const int bh = u & 127, b = bh >> 2, h = bh & 3, qt = u >> 7, q0 = qt * 128;
                        const size_t rb = (size_t)b * SEQ;
                        f32x4 o[1][16]; float ll[1];
                        attn_core3<256, 256, 0, 1, 64>(lds, BIG + (rb + q0) * 1024 + h * 256, 1024, KV + (size_t)b * 256 * 2048 + h * 256, 2048, KV + (size_t)b * 256 * 2048 + 1024 + h * 256, 2048, q0, 4, 0.0625f * LOG2E, 0.f, o, ll);
                        const float iv = 1.0f / ll[0]; const size_t row = rb + q0 + wave * 16 + r;
#pragma unroll
                        for (int cb = 0; cb < 16; ++cb) { const f32x4 v = o[0][cb] * iv; u32x2 wv; wv.x = cvt_pk_bf16(v[0], v[1]); wv.y = cvt_pk_bf16(v[2], v[3]);
                            *(u32x2*)(CAT + row * 1024 + h * 256 + cb * 16 + g4 * 4) = wv; }
                    }
                }
                __syncthreads();
                GRID_BAR();
                asel = 1; boff = OFF_WO; Kres = 1024; sres = 1.0f;
            }
            { PHASE_IDS(); int si_ = si; asm volatile("" : "+s"(si_)); LN_CTX(); pg8::Gemm g{asel ? CAT : BIG, Wl + boff, T_TOK, 1024, Kres}; pg8::StaticOrder S; S.init(T_TOK, 1024, G, blk);
              const float* gpv = kcur ? P.in[2] + (size_t)(kcur - 1) * 1024 : (const float*)(ws + WS_ONES); const float* bpv = kcur ? P.in[3] + (size_t)(kcur - 1) * 1024 : (const float*)(ws + WS_ZEROS);
              { LAS float* gl = (LAS float*)(lds + 147456); for (int i = tid; i < 1024; i += 512) { gl[i] = gpv[i]; gl[1024 + i] = bpv[i]; } __syncthreads(); }
              pg8::EpiResid E{X, XB, Scur, Snxt, gpv, bpv, DN_ALPHA, sres}; pg8::gemm_phase<pg8::EpiResid, pg8::StaticOrder, true, true>(lds, g, S, E); }
            GRID_BAR();
            if (lcur == 3 && si == 3) { PHASE_IDS();
                const float* gp = P.in[2] + (size_t)15 * 1024; const float* bp = P.in[3] + (size_t)15 * 1024;
                f32x4 gv[4], bv[4];
#pragma unroll
                for (int j = 0; j < 4; ++j) { gv[j] = ((const f32x4*)gp)[lane + 64 * j]; bv[j] = ((const f32x4*)bp)[lane + 64 * j]; }
                for (int mrow0 = gw; mrow0 < T_TOK; mrow0 += 2 * NGW) {
                    f32x4 v[2][4];
#pragma unroll
                    for (int q = 0; q < 2; ++q) { const int mrow = (mrow0 + q * NGW < T_TOK) ? mrow0 + q * NGW : mrow0;
#pragma unroll
                        for (int j = 0; j < 4; ++j) { const unsigned long long hw = ((const unsigned long long*)(XB + (size_t)mrow * 1024))[lane + 64 * j], lw = ((const unsigned long long*)(X + (size_t)mrow * 1024))[256 + lane + 64 * j];
                            const unsigned h0 = (unsigned)hw, h1 = (unsigned)(hw >> 32), l0 = (unsigned)lw, l1 = (unsigned)(lw >> 32);
                            v[q][j][0] = bflo(h0) + bflo(l0); v[q][j][1] = bfhi(h0) + bfhi(l0); v[q][j][2] = bflo(h1) + bflo(l1); v[q][j][3] = bfhi(h1) + bfhi(l1); } }
#pragma unroll
                    for (int q = 0; q < 2; ++q) { const int mrow = mrow0 + q * NGW; if (mrow < T_TOK) {
                        f32x4* xr = (f32x4*)(X + (size_t)mrow * 1024) + lane; float s = 0.f;
#pragma unroll
                        for (int j = 0; j < 4; ++j) s += (v[q][j][0] + v[q][j][1]) + (v[q][j][2] + v[q][j][3]);
                        const float mean = wave_sum(s) * (1.0f / 1024.0f); float s2 = 0.f;
#pragma unroll
                        for (int j = 0; j < 4; ++j) { v[q][j] = v[q][j] - mean; s2 += (v[q][j][0] * v[q][j][0] + v[q][j][1] * v[q][j][1]) + (v[q][j][2] * v[q][j][2] + v[q][j][3] * v[q][j][3]); }
                        const float rstd = rsqrtf(wave_sum(s2) * (1.0f / 1024.0f) + LN_EPS);
#pragma unroll
                        for (int j = 0; j < 4; ++j) { const f32x4 y = v[q][j] * rstd * gv[j] + bv[j]; xr[64 * j] = y; } } }
                }
            }
        }
    }
}

extern "C" void kernel_launch(void* const* d_in, const int* in_sizes, int n_in, void* d_out, int out_size, void* d_ws, size_t ws_size, hipStream_t stream) {
    static int grid_blocks = 0;
    if (grid_blocks == 0) {
        if (n_in != 32 || out_size != T_TOK * DM || ws_size < WS_END) { fprintf(stderr, "kernel_launch: unexpected shapes (n_in %d out %d ws %zu)\n", n_in, out_size, ws_size); grid_blocks = -1; return; }
        int dev = 0, cus = 0, per_cu = 0;
        hipGetDevice(&dev); hipDeviceGetAttribute(&cus, hipDeviceAttributeMultiprocessorCount, dev);
        if (hipFuncSetAttribute((const void*)mega_fwd, hipFuncAttributeMaxDynamicSharedMemorySize, LDS_BYTES) != hipSuccess) { fprintf(stderr, "kernel_launch: hipFuncSetAttribute failed\n"); }
        if (hipOccupancyMaxActiveBlocksPerMultiprocessor(&per_cu, (const void*)mega_fwd, 512, LDS_BYTES) != hipSuccess || per_cu < 1) { fprintf(stderr, "kernel_launch: occupancy query says %d\n", per_cu); per_cu = 1; }
        (void)hipGetLastError();
        grid_blocks = cus * 1;
        fprintf(stderr, "kernel_launch: cus %d per_cu %d grid %d\n", cus, per_cu, grid_blocks);
    }
    if (grid_blocks < 0) return;
    Params p{};
    for (int i = 0; i < 32; ++i) p.in[i] = (const float*)d_in[i];
    p.out = (float*)d_out; p.ws = (unsigned char*)d_ws;
    if (hipMemsetAsync(d_ws, 0, 16384, stream) != hipSuccess) { fprintf(stderr, "kernel_launch: memset failed\n"); return; }
    void* args[] = {&p};
    hipError_t e = hipLaunchCooperativeKernel((const void*)mega_fwd, dim3(grid_blocks), dim3(512), args, LDS_BYTES, stream);
    if (e != hipSuccess) fprintf(stderr, "cooperative launch failed: %s (grid %d)\n", hipGetErrorString(e), grid_blocks);
}
```

```cpp
#include <hip/hip_runtime.h>
#include <hip/hip_cooperative_groups.h>
#include <cstdio>
#include <cstdint>
#include <type_traits>
namespace cg = cooperative_groups;
__device__ __forceinline__ float xsum16(float v) { auto rr = __builtin_amdgcn_permlane16_swap(__float_as_uint(v), __float_as_uint(v), false, false); return __uint_as_float(rr[0]) + __uint_as_float(rr[1]); }
__device__ __forceinline__ float xsum32(float v) { auto rr = __builtin_amdgcn_permlane32_swap(__float_as_uint(v), __float_as_uint(v), false, false); return __uint_as_float(rr[0]) + __uint_as_float(rr[1]); }
__device__ __forceinline__ float xmax16(float v) { auto rr = __builtin_amdgcn_permlane16_swap(__float_as_uint(v), __float_as_uint(v), false, false); return fmaxf(__uint_as_float(rr[0]), __uint_as_float(rr[1])); }
__device__ __forceinline__ float xmax32(float v) { auto rr = __builtin_amdgcn_permlane32_swap(__float_as_uint(v), __float_as_uint(v), false, false); return fmaxf(__uint_as_float(rr[0]), __uint_as_float(rr[1])); }
__device__ __forceinline__ float xsum_rows(float v) { return xsum32(xsum16(v)); }
__device__ __forceinline__ float xmax_rows(float v) { return xmax32(xmax16(v)); }
namespace pg8 {
#define PG8_LAS __attribute__((address_space(3)))
typedef unsigned short bf16_t;
typedef short bf16x8 __attribute__((ext_vector_type(8)));
typedef float f32x4 __attribute__((ext_vector_type(4)));
typedef unsigned u32x4 __attribute__((ext_vector_type(4)));
constexpr int BM = 256, BK = 64, HALF = 128, HTB = HALF * BK * 2  , STAGE_BYTES = 8 * HTB, NXCD = 8, WGM = 8;

__host__ __device__ __forceinline__ int lds_byte(int r, int c) { const int st = (r >> 4) * 2 + (c >> 5), rr = r & 15, cc = c & 31, ob = rr * 64 + cc * 2; return st * 1024 + (ob ^ (((ob >> 9) & 1) << 5)); }
__host__ __device__ __forceinline__ void stage_rc(int b, int& R, int& C) { const int st = b / 1024, sb = b % 1024, swz = sb ^ (((sb >> 9) & 1) << 5); R = (st >> 1) * 16 + swz / 64; C = (st & 1) * 32 + (swz % 64) / 2; }
__host__ __device__ __forceinline__ int perm32(int rho) { const int n = rho >> 4, i = rho & 15; return 8 * (i >> 2) + 4 * n + (i & 3); }

struct Unit { int pm, pn; };
struct Gemm { const bf16_t* A; const bf16_t* Bt; int M, N, K; };

struct StaticOrder {
    int nM, nN, nwg, G, c;
    __host__ __device__ void init(int M, int N, int G_, int c_) { nM = M / BM; nN = N / BM; nwg = nM * nN; G = G_; c = c_; }
    __host__ __device__ bool next(int i, Unit& u) const {
        const long L = (long)i * G + c; if (L >= nwg) return false;
        int wgid = (int)L; { const int q = nwg / NXCD, r = nwg % NXCD, xcd = wgid % NXCD, off = wgid / NXCD; wgid = (xcd < r ? xcd * (q + 1) : r * (q + 1) + (xcd - r) * q) + off; }
        const int nig = WGM * nN, gid = wgid / nig, fm = gid * WGM, gsz = (nM - fm) < WGM ? (nM - fm) : WGM;
        u.pm = fm + ((wgid % nig) % gsz); u.pn = (wgid % nig) / gsz; return true;
    }
    __device__ __forceinline__ void a_ready(const Unit&) const {}
    __device__ __forceinline__ void done(const Unit&) const {}
};

__device__ __forceinline__ unsigned cvt_pk_bf16(float lo, float hi) { unsigned r; asm volatile("v_cvt_pk_bf16_f32 %0, %1, %2" : "=v"(r) : "v"(lo), "v"(hi)); return r; }
typedef float f32x2 __attribute__((ext_vector_type(2)));
__device__ __forceinline__ float fast_sigmoid(float x) { return __builtin_amdgcn_rcpf(1.0f + __expf(-x)); }

struct LnFix { const float* st; const float* c1; const float* c2; };
__device__ __forceinline__ void ln_row(const float* st, int row, int fq, float& rs, float& ms) {
    f32x2 v = *(const f32x2*)(st + (unsigned)(8 * row + 2 * fq));
    v.x = xsum_rows(v.x); v.y = xsum_rows(v.y);
    const float mean = v.x * (1.0f / 1024.0f); const float var = v.y * (1.0f / 1024.0f) - mean * mean;
    rs = __builtin_amdgcn_rsqf(var + 1e-5f); ms = rs * mean;
}
struct EpiSwiglu {
    static constexpr bool PERM = true, AFTER_DRAIN = false;
    bf16_t* O; int ldo; LnFix ln;
    __device__ __forceinline__ void operator()(const f32x4 (&acc)[2][2][4][2], const Unit& u, int wr, int wc, int fr, int fq, PG8_LAS unsigned char* ldsb) const {
        const int row0 = u.pm * BM + wr * 64 + fr; const int col0 = u.pn * HALF + wc * 32 + 8 * fq;
        const int brow = u.pn * BM + wc * 32 + 8 * fq;
        const PG8_LAS unsigned* CV = (const PG8_LAS unsigned*)(ldsb + 131072);
        PG8_LAS f32x2* ST = (PG8_LAS f32x2*)(ldsb + 153600);
        volatile PG8_LAS int* TAG = (volatile PG8_LAS int*)(ldsb + 155648);
        float rsv[2][4], msv[2][4];
        if (TAG[wr] != u.pm) {
#pragma unroll
            for (int ai = 0; ai < 2; ++ai)
#pragma unroll
                for (int m = 0; m < 4; ++m) { ln_row(ln.st, row0 + ai * HALF + m * 16, fq, rsv[ai][m], msv[ai][m]);
                    f32x2 pr; pr.x = rsv[ai][m]; pr.y = msv[ai][m]; ST[ai * HALF + wr * 64 + m * 16 + fr] = pr; }
            asm volatile("s_waitcnt lgkmcnt(0)" ::: "memory");
            TAG[wr] = u.pm;
        } else {
#pragma unroll
            for (int ai = 0; ai < 2; ++ai)
#pragma unroll
                for (int m = 0; m < 4; ++m) { const f32x2 pr = ST[ai * HALF + wr * 64 + m * 16 + fr]; rsv[ai][m] = pr.x; msv[ai][m] = pr.y; }
        }
        float c1g[8], c2g[8], c1u[8], c2u[8];
        { const u32x4 g0 = *(const PG8_LAS u32x4*)(CV + brow), g1 = *(const PG8_LAS u32x4*)(CV + brow + 4), u0 = *(const PG8_LAS u32x4*)(CV + brow + HALF), u1 = *(const PG8_LAS u32x4*)(CV + brow + HALF + 4);
#pragma unroll
          for (int i = 0; i < 4; ++i) { c1g[i] = __uint_as_float(g0[i] << 16); c2g[i] = __uint_as_float(g0[i] & 0xffff0000u); c1g[4 + i] = __uint_as_float(g1[i] << 16); c2g[4 + i] = __uint_as_float(g1[i] & 0xffff0000u);
              c1u[i] = __uint_as_float(u0[i] << 16); c2u[i] = __uint_as_float(u0[i] & 0xffff0000u); c1u[4 + i] = __uint_as_float(u1[i] << 16); c2u[4 + i] = __uint_as_float(u1[i] & 0xffff0000u); } }
#pragma unroll
        for (int ai = 0; ai < 2; ++ai)
#pragma unroll
            for (int m = 0; m < 4; ++m) {
                bf16_t* p = O + (size_t)(row0 + ai * HALF + m * 16) * ldo + col0;
                const float rs = rsv[ai][m], ms = msv[ai][m];
                float v[8];
#pragma unroll
                for (int n = 0; n < 2; ++n)
#pragma unroll
                    for (int i = 0; i < 4; ++i) { const int e = n * 4 + i; const float g = acc[ai][0][m][n][i] * rs - ms * c1g[e] + c2g[e], up = acc[ai][1][m][n][i] * rs - ms * c1u[e] + c2u[e]; v[e] = g * fast_sigmoid(g) * up; }
                u32x4 w; w.x = cvt_pk_bf16(v[0], v[1]); w.y = cvt_pk_bf16(v[2], v[3]); w.z = cvt_pk_bf16(v[4], v[5]); w.w = cvt_pk_bf16(v[6], v[7]);
                *(u32x4*)p = w;
            }
    }
};
struct EpiResid {
    static constexpr bool PERM = false, AFTER_DRAIN = false;
    float* X; bf16_t* PB; const float* stp; float* stn; const float* gp; const float* bp; float alpha, s;
    template <int AI, int M0, int NR>
    __device__ __forceinline__ void batch(const f32x4 (&acc)[2][2][4][2], int row0, int col0, int wr, int wc, int fr, int fq, PG8_LAS float* red, const PG8_LAS float* gl) const {
        f32x2 xh[NR][2][2], xl[NR][2][2], stv[NR];
#pragma unroll
        for (int mm = 0; mm < NR; ++mm) { const unsigned rr_ = (unsigned)(row0 + AI * HALF + (M0 + mm) * 16); stv[mm] = *(const f32x2*)(stp + (8u * rr_ + 2u * (unsigned)fq));
#pragma unroll
            for (int bj = 0; bj < 2; ++bj)
#pragma unroll
                for (int n = 0; n < 2; ++n) { const unsigned cc_ = (unsigned)(col0 + bj * HALF + n * 16);
                    xh[mm][bj][n] = *(const f32x2*)(PB + (rr_ * 1024u + cc_)); xl[mm][bj][n] = *(const f32x2*)((const bf16_t*)X + (rr_ * 2048u + 1024u + cc_)); } }
#pragma unroll
        for (int mm = 0; mm < NR; ++mm) { const int m = M0 + mm; const int row = row0 + AI * HALF + m * 16;
            float rs, ms; { f32x2 v = stv[mm]; v.x = xsum_rows(v.x); v.y = xsum_rows(v.y);
              const float mean = v.x * (1.0f / 1024.0f); const float var = v.y * (1.0f / 1024.0f) - mean * mean; rs = __builtin_amdgcn_rsqf(var + 1e-5f); ms = rs * mean; }
            const unsigned ro = (unsigned)row * 1024u + (unsigned)col0;
            float sm = 0.f, sq = 0.f;
#pragma unroll
            for (int bj = 0; bj < 2; ++bj)
#pragma unroll
                for (int n = 0; n < 2; ++n) { const unsigned hw0 = __float_as_uint(xh[mm][bj][n].x), hw1 = __float_as_uint(xh[mm][bj][n].y), lw0 = __float_as_uint(xl[mm][bj][n].x), lw1 = __float_as_uint(xl[mm][bj][n].y);
                    f32x4 x; x[0] = __uint_as_float(hw0 << 16) + __uint_as_float(lw0 << 16); x[1] = __uint_as_float(hw0 & 0xffff0000u) + __uint_as_float(lw0 & 0xffff0000u);
                    x[2] = __uint_as_float(hw1 << 16) + __uint_as_float(lw1 << 16); x[3] = __uint_as_float(hw1 & 0xffff0000u) + __uint_as_float(lw1 & 0xffff0000u);
                    const f32x4 gvv = *(const PG8_LAS f32x4*)(gl + bj * HALF + n * 16), bvv = *(const PG8_LAS f32x4*)(gl + 1024 + bj * HALF + n * 16);
                    const f32x4 xn = (x * rs - ms) * gvv + bvv; const f32x4 y = xn * alpha + acc[AI][bj][m][n] * s;
                    const unsigned nh0 = cvt_pk_bf16(y[0], y[1]), nh1 = cvt_pk_bf16(y[2], y[3]);
                    f32x2 w; w.x = __uint_as_float(nh0); w.y = __uint_as_float(nh1); *(f32x2*)(PB + (ro + (unsigned)(bj * HALF + n * 16))) = w;
                    f32x2 wl; wl.x = __uint_as_float(cvt_pk_bf16(y[0] - __uint_as_float(nh0 << 16), y[1] - __uint_as_float(nh0 & 0xffff0000u))); wl.y = __uint_as_float(cvt_pk_bf16(y[2] - __uint_as_float(nh1 << 16), y[3] - __uint_as_float(nh1 & 0xffff0000u)));
                    *(f32x2*)((bf16_t*)X + ((unsigned)row * 2048u + 1024u + (unsigned)(col0 + bj * HALF + n * 16))) = wl;
                    sm += (y[0] + y[1]) + (y[2] + y[3]); sq += (y[0] * y[0] + y[1] * y[1]) + (y[2] * y[2] + y[3] * y[3]); }
            sm = xsum_rows(sm); sq = xsum_rows(sq);
            if (fq == 0) { f32x2 pr; pr.x = sm; pr.y = sq; *(PG8_LAS f32x2*)(red + ((AI * HALF + wr * 64 + m * 16 + fr) * 4 + wc) * 2) = pr; }
        }
        asm volatile("" ::: "memory");
    }
    __device__ __forceinline__ void operator()(const f32x4 (&acc)[2][2][4][2], const Unit& u, int wr, int wc, int fr, int fq, PG8_LAS unsigned char* ldsb) const {
        const int row0 = u.pm * BM + wr * 64 + fr; const int col0 = u.pn * BM + wc * 32 + 4 * fq;
        PG8_LAS float* red = (PG8_LAS float*)(ldsb + 131072);
        const PG8_LAS float* gl = (const PG8_LAS float*)(ldsb + 147456) + col0;
        batch<0, 0, 2>(acc, row0, col0, wr, wc, fr, fq, red, gl);
        batch<0, 2, 2>(acc, row0, col0, wr, wc, fr, fq, red, gl);
        batch<1, 0, 4>(acc, row0, col0, wr, wc, fr, fq, red, gl);
        asm volatile("s_waitcnt lgkmcnt(0)" ::: "memory"); __builtin_amdgcn_s_barrier(); asm volatile("" ::: "memory");
        { const int t = wr * 256 + wc * 64 + fq * 16 + fr;
          if (t < 256) { const PG8_LAS f32x4* rr = (const PG8_LAS f32x4*)(red + t * 8); const f32x4 a = rr[0], b = rr[1];
              f32x2 o; o.x = (a[0] + a[2]) + (b[0] + b[2]); o.y = (a[1] + a[3]) + (b[1] + b[3]); *(f32x2*)(stn + 8 * (size_t)(u.pm * BM + t) + 2 * u.pn) = o; } }
    }
};
struct EpiStore {
    static constexpr bool PERM = true, AFTER_DRAIN = false;
    bf16_t* O; int ldc; LnFix ln;
    __device__ __forceinline__ void operator()(const f32x4 (&acc)[2][2][4][2], const Unit& u, int wr, int wc, int fr, int fq, PG8_LAS unsigned char* ldsb) const {
        const int row0 = u.pm * BM + wr * 64 + fr; const int col0 = u.pn * BM + wc * 32 + 8 * fq;
        const bool has_ln = ln.st != nullptr;
        f32x4 c1v[2][2], c2v[2][2]; float rsv[2][4], msv[2][4];
#pragma unroll
        for (int ai = 0; ai < 2; ++ai)
#pragma unroll
            for (int m = 0; m < 4; ++m) { rsv[ai][m] = 1.f; msv[ai][m] = 0.f; }
#pragma unroll
        for (int bj = 0; bj < 2; ++bj)
#pragma unroll
            for (int n = 0; n < 2; ++n) { c1v[bj][n] = (f32x4){0.f, 0.f, 0.f, 0.f}; c2v[bj][n] = (f32x4){0.f, 0.f, 0.f, 0.f}; }
        if (has_ln) {
            const PG8_LAS unsigned* CV = (const PG8_LAS unsigned*)(ldsb + 131072);
            PG8_LAS f32x2* ST = (PG8_LAS f32x2*)(ldsb + 153600);
            volatile PG8_LAS int* TAG = (volatile PG8_LAS int*)(ldsb + 155648);
            if (TAG[wr] != u.pm) {
#pragma unroll
                for (int ai = 0; ai < 2; ++ai)
#pragma unroll
                    for (int m = 0; m < 4; ++m) { ln_row(ln.st, row0 + ai * HALF + m * 16, fq, rsv[ai][m], msv[ai][m]);
                        f32x2 pr; pr.x = rsv[ai][m]; pr.y = msv[ai][m]; ST[ai * HALF + wr * 64 + m * 16 + fr] = pr; }
                asm volatile("s_waitcnt lgkmcnt(0)" ::: "memory");
                TAG[wr] = u.pm;
            } else {
#pragma unroll
                for (int ai = 0; ai < 2; ++ai)
#pragma unroll
                    for (int m = 0; m < 4; ++m) { const f32x2 pr = ST[ai * HALF + wr * 64 + m * 16 + fr]; rsv[ai][m] = pr.x; msv[ai][m] = pr.y; }
            }
#pragma unroll
            for (int bj = 0; bj < 2; ++bj)
#pragma unroll
                for (int n = 0; n < 2; ++n) { const u32x4 cw = *(const PG8_LAS u32x4*)(CV + col0 + bj * HALF + 4 * n);
#pragma unroll
                    for (int i = 0; i < 4; ++i) { c1v[bj][n][i] = __uint_as_float(cw[i] << 16); c2v[bj][n][i] = __uint_as_float(cw[i] & 0xffff0000u); } }
        }
#pragma unroll
        for (int ai = 0; ai < 2; ++ai)
#pragma unroll
            for (int m = 0; m < 4; ++m) {
                bf16_t* rowp = O + (size_t)(row0 + ai * HALF + m * 16) * ldc + col0;
                const float rs = rsv[ai][m], ms = msv[ai][m];
#pragma unroll
                for (int bj = 0; bj < 2; ++bj) { const f32x4 v0 = acc[ai][bj][m][0] * rs - c1v[bj][0] * ms + c2v[bj][0], v1 = acc[ai][bj][m][1] * rs - c1v[bj][1] * ms + c2v[bj][1];
                    u32x4 w; w.x = cvt_pk_bf16(v0[0], v0[1]); w.y = cvt_pk_bf16(v0[2], v0[3]); w.z = cvt_pk_bf16(v1[0], v1[1]); w.w = cvt_pk_bf16(v1[2], v1[3]);
                    *(u32x4*)(rowp + bj * HALF) = w; }
            }
    }
};
struct EpiLru {
    static constexpr bool PERM = true, AFTER_DRAIN = false;
    unsigned* AB; const bf16_t* XC; const float* gb; const float* lam;
    __device__ __forceinline__ void operator()(const f32x4 (&acc)[2][2][4][2], const Unit& u, int wr, int wc, int fr, int fq, PG8_LAS unsigned char* ldsb) const {
        const int row0 = u.pm * BM + wr * 64 + fr; const int ch0 = u.pn * HALF + wc * 32 + 8 * fq;
        float sp[8], br[8], bi[8];
#pragma unroll
        for (int i = 0; i < 8; ++i) { sp[i] = lam[ch0 + i]; br[i] = gb[ch0 + i]; bi[i] = gb[512 + ch0 + i]; }
        u32x4 xwv[2][4];
#pragma unroll
        for (int ai = 0; ai < 2; ++ai)
#pragma unroll
            for (int m = 0; m < 4; ++m) xwv[ai][m] = *(const u32x4*)(XC + ((unsigned)(row0 + ai * HALF + m * 16) * 512u + (unsigned)ch0));
#pragma unroll
        for (int ai = 0; ai < 2; ++ai)
#pragma unroll
            for (int m = 0; m < 4; ++m) {
                const size_t ro = (size_t)(row0 + ai * HALF + m * 16) * 512 + ch0;
                const u32x4 xw = xwv[ai][m];
                unsigned ow[8];
#pragma unroll
                for (int n = 0; n < 2; ++n)
#pragma unroll
                    for (int i = 0; i < 4; ++i) { const int e = n * 4 + i;
                        const unsigned wd = xw[e >> 1]; const float xc = __uint_as_float((e & 1) ? (wd & 0xffff0000u) : (wd << 16));
                        const float r = fast_sigmoid(acc[ai][0][m][n][i] + br[e]), ig = fast_sigmoid(acc[ai][1][m][n][i] + bi[e]);
                        const float la = sp[e] * r;
                        const float bb = __builtin_sqrtf(fmaxf(1.0f - __expf(2.0f * la), 0.f)) * (ig * xc);
                        ow[e] = cvt_pk_bf16(la * 1.4426950408889634f, bb); }
                u32x4 w0, w1; w0.x = ow[0]; w0.y = ow[1]; w0.z = ow[2]; w0.w = ow[3]; w1.x = ow[4]; w1.y = ow[5]; w1.z = ow[6]; w1.w = ow[7];
                *(u32x4*)(AB + ro) = w0; *(u32x4*)(AB + ro + 4) = w1;
            }
    }
};
struct EpiGlu {
    static constexpr bool PERM = true, AFTER_DRAIN = false;
    bf16_t* O; int ldo; const bf16_t* Zs; const float* bias;
    __device__ __forceinline__ void operator()(const f32x4 (&acc)[2][2][4][2], const Unit& u, int wr, int wc, int fr, int fq, PG8_LAS unsigned char* ldsb) const {
        const int row0 = u.pm * BM + wr * 64 + fr; const int col0 = u.pn * BM + wc * 32 + 8 * fq;
#pragma unroll
        for (int ai = 0; ai < 2; ++ai) {
            u32x4 zv[4][2];
#pragma unroll
            for (int m = 0; m < 4; ++m)
#pragma unroll
                for (int bj = 0; bj < 2; ++bj) zv[m][bj] = *(const u32x4*)(Zs + ((unsigned)(row0 + ai * HALF + m * 16) * 512u + (unsigned)(col0 + bj * HALF)));
#pragma unroll
            for (int m = 0; m < 4; ++m) {
                const int row = row0 + ai * HALF + m * 16;
#pragma unroll
                for (int bj = 0; bj < 2; ++bj) {
                    const int c = col0 + bj * HALF;
                    const u32x4 zw = zv[m][bj];
                    float v[8];
#pragma unroll
                    for (int n = 0; n < 2; ++n)
#pragma unroll
                        for (int i = 0; i < 4; ++i) { const int e = n * 4 + i; const unsigned wd = zw[e >> 1];
                            const float z = __uint_as_float((e & 1) ? (wd & 0xffff0000u) : (wd << 16));
                            v[e] = z * fast_sigmoid(acc[ai][bj][m][n][i] + bias[c + e]); }
                    u32x4 w; w.x = cvt_pk_bf16(v[0], v[1]); w.y = cvt_pk_bf16(v[2], v[3]); w.z = cvt_pk_bf16(v[4], v[5]); w.w = cvt_pk_bf16(v[6], v[7]);
                    *(u32x4*)(O + (size_t)row * ldo + c) = w;
                }
            }
            asm volatile("" ::: "memory");
        }
    }
};
template <class Epi, class Sched, bool ALIGN_EPI = false, bool SP2 = false>
__device__ __forceinline__ void gemm_phase(PG8_LAS unsigned char* lds, const Gemm g, const Sched& S, const Epi& E) {
    int tid_ = threadIdx.x; asm volatile("" : "+v"(tid_)); const int tid = tid_, wid = __builtin_amdgcn_readfirstlane(tid >> 6), lane = tid & 63, wr = wid >> 2, wc = wid & 3, fr = lane & 15, fq = lane >> 4;
    const bf16_t* gA_ = g.A; const bf16_t* gB_ = g.Bt; int K = g.K; asm volatile("" : "+s"(gA_), "+s"(gB_), "+s"(K)); const int nt = K / BK;
    unsigned voffA[2], voffB[2];
#pragma unroll
    for (int i = 0; i < 2; ++i) { int R, C; stage_rc(tid * 16 + i * 8192, R, C); const int Rb = Epi::PERM ? ((R & ~31) + perm32(R & 31)) : R;
        voffA[i] = (unsigned)(R * K + C) * 2u; voffB[i] = (unsigned)(Rb * K + C) * 2u; }
    const size_t kstep = (size_t)(BK * 2);
    const size_t hstep = (size_t)HALF * K * 2;
    const size_t tstep = 2 * hstep;
    const unsigned ldsw = (unsigned)wid * 1024u;
    const int aoff = lds_byte(wr * 64 + fr, fq * 8), boff = lds_byte(wc * 32 + fr, fq * 8);
#define PG8_SA(b, h) (((b) * 2 + (h)) * HTB)
#define PG8_SB(b, h) ((4 + (b) * 2 + (h)) * HTB)
#define PG8_STAGE(bufoff, gbase, voff) do { _Pragma("unroll") for (int _i = 0; _i < 2; ++_i) \
        __builtin_amdgcn_global_load_lds((const unsigned*)((const char*)(gbase) + (voff)[_i]), (PG8_LAS unsigned*)(lds + (bufoff) + ldsw + _i * 8192), 16, 0, 0); } while (0)
#define PG8_LDA(dst, b, h) do { _Pragma("unroll") for (int m = 0; m < 4; ++m) _Pragma("unroll") for (int k = 0; k < 2; ++k) dst[m][k] = *(const PG8_LAS bf16x8*)(lds + PG8_SA(b, h) + aoff + m * 2048 + k * 1024); } while (0)
#define PG8_LDB(dst, b, h) do { _Pragma("unroll") for (int n = 0; n < 2; ++n) _Pragma("unroll") for (int k = 0; k < 2; ++k) dst[n][k] = *(const PG8_LAS bf16x8*)(lds + PG8_SB(b, h) + boff + n * 2048 + k * 1024); } while (0)
#define PG8_MMA(ai, bj, At, Bt) do { __builtin_amdgcn_s_setprio(1); _Pragma("unroll") for (int m = 0; m < 4; ++m) _Pragma("unroll") for (int n = 0; n < 2; ++n) _Pragma("unroll") for (int k = 0; k < 2; ++k) \
        acc[ai][bj][m][n] = __builtin_amdgcn_mfma_f32_16x16x32_bf16(Bt[n][k], At[m][k], acc[ai][bj][m][n], 0, 0, 0); __builtin_amdgcn_s_setprio(0); } while (0)
#define PG8_WAIT_V(n) asm volatile("s_waitcnt vmcnt(" #n ")" ::: "memory")
#define PG8_WAIT_L(n) asm volatile("s_waitcnt lgkmcnt(" #n ")" ::: "memory")
#define PG8_BAR __builtin_amdgcn_s_barrier()
#define PG8_SCHED __builtin_amdgcn_sched_barrier(0)
    Unit cur, nxt; int ui = 0;
    if (!S.next(0, cur)) return;
    f32x4 acc[2][2][4][2];
#pragma unroll
    for (int a = 0; a < 2; ++a)
#pragma unroll
        for (int b = 0; b < 2; ++b)
#pragma unroll
            for (int m = 0; m < 4; ++m)
#pragma unroll
                for (int n = 0; n < 2; ++n) acc[a][b][m][n] = (f32x4){0.f, 0.f, 0.f, 0.f};
    bf16x8 At[4][2], B0[2][2], B1[2][2];
    const char* cA = (const char*)gA_ + (size_t)cur.pm * tstep; const char* cB = (const char*)gB_ + (size_t)cur.pn * tstep;
    S.a_ready(cur);
    if constexpr (SP2) {
        PG8_STAGE(PG8_SB(0, 0), cB, voffB); PG8_STAGE(PG8_SB(0, 1), cB + hstep, voffB); PG8_STAGE(PG8_SA(0, 0), cA, voffA); PG8_STAGE(PG8_SA(0, 1), cA + hstep, voffA);
        if (wr == 1) PG8_BAR;
        PG8_WAIT_V(2); PG8_BAR;
        PG8_STAGE(PG8_SB(1, 0), cB + kstep, voffB); PG8_STAGE(PG8_SA(1, 0), cA + kstep, voffA); PG8_STAGE(PG8_SB(1, 1), cB + hstep + kstep, voffB);
        PG8_WAIT_V(6); PG8_BAR;
    } else {
        PG8_STAGE(PG8_SB(0, 0), cB, voffB); PG8_STAGE(PG8_SA(0, 0), cA, voffA); PG8_STAGE(PG8_SB(0, 1), cB + hstep, voffB); PG8_STAGE(PG8_SA(0, 1), cA + hstep, voffA);
        if (wr == 1) PG8_BAR;
        PG8_WAIT_V(4); PG8_BAR;
        PG8_STAGE(PG8_SB(1, 0), cB + kstep, voffB); PG8_STAGE(PG8_SA(1, 0), cA + kstep, voffA); PG8_STAGE(PG8_SB(1, 1), cB + hstep + kstep, voffB);
        PG8_WAIT_V(6); PG8_BAR;
    }
    for (;;) {
        const bool has_next = S.next(ui + 1, nxt);
        const char* nA = has_next ? (const char*)gA_ + (size_t)nxt.pm * tstep : cA; const char* nB = has_next ? (const char*)gB_ + (size_t)nxt.pn * tstep : cB;
        for (int t = 0; t < nt; t += 2) {
            const bool last = (t == nt - 2);
            const char* a1 = cA + (size_t)(t + 1) * kstep;
            const char* a2 = last ? nA : cA + (size_t)(t + 2) * kstep; const char* b2 = last ? nB : cB + (size_t)(t + 2) * kstep;
            const char* a3 = a2 + kstep; const char* b3 = b2 + kstep;
            if (last && has_next) S.a_ready(nxt);
            if constexpr (SP2) {
            PG8_LDB(B0, 0, 0); PG8_LDB(B1, 0, 1); PG8_SCHED; PG8_LDA(At, 0, 0); PG8_STAGE(PG8_SA(1, 1), a1 + hstep, voffA);
            PG8_WAIT_V(8); PG8_WAIT_L(0); PG8_BAR; PG8_MMA(0, 0, At, B0); PG8_MMA(0, 1, At, B1); PG8_BAR; PG8_SCHED;
            PG8_LDA(At, 0, 1); PG8_STAGE(PG8_SB(0, 0), b2, voffB); PG8_STAGE(PG8_SB(0, 1), b2 + hstep, voffB); PG8_STAGE(PG8_SA(0, 0), a2, voffA);
            PG8_WAIT_V(8); PG8_WAIT_L(0); PG8_BAR; PG8_MMA(1, 0, At, B0); PG8_MMA(1, 1, At, B1); PG8_BAR; PG8_SCHED;
            PG8_LDB(B0, 1, 0); PG8_LDB(B1, 1, 1); PG8_SCHED; PG8_LDA(At, 1, 0); PG8_STAGE(PG8_SA(0, 1), a2 + hstep, voffA);
            PG8_WAIT_V(8); PG8_WAIT_L(0); PG8_BAR; PG8_MMA(0, 0, At, B0); PG8_MMA(0, 1, At, B1); PG8_BAR; PG8_SCHED;
            PG8_LDA(At, 1, 1); PG8_STAGE(PG8_SB(1, 0), b3, voffB); PG8_STAGE(PG8_SB(1, 1), b3 + hstep, voffB); PG8_STAGE(PG8_SA(1, 0), a3, voffA);
            PG8_WAIT_V(8); PG8_WAIT_L(0); PG8_BAR; PG8_MMA(1, 0, At, B0); PG8_MMA(1, 1, At, B1); PG8_BAR; PG8_SCHED;
            } else {
            PG8_LDB(B0, 0, 0); PG8_SCHED; PG8_LDA(At, 0, 0); PG8_STAGE(PG8_SA(1, 1), a1 + hstep, voffA);
            PG8_WAIT_L(8); PG8_BAR; PG8_WAIT_L(0); PG8_MMA(0, 0, At, B0); PG8_BAR; PG8_SCHED;
            PG8_LDB(B1, 0, 1); PG8_STAGE(PG8_SB(0, 0), b2, voffB);
            PG8_BAR; PG8_WAIT_L(0); PG8_MMA(0, 1, At, B1); PG8_BAR;
            PG8_LDA(At, 0, 1); PG8_STAGE(PG8_SA(0, 0), a2, voffA);
            PG8_BAR; PG8_WAIT_L(0); PG8_MMA(1, 0, At, B0); PG8_BAR; PG8_SCHED;
            PG8_STAGE(PG8_SB(0, 1), b2 + hstep, voffB);
            PG8_WAIT_V(6); PG8_BAR; PG8_MMA(1, 1, At, B1); PG8_BAR;
            PG8_LDB(B0, 1, 0); PG8_SCHED; PG8_LDA(At, 1, 0); PG8_STAGE(PG8_SA(0, 1), a2 + hstep, voffA);
            PG8_WAIT_L(8); PG8_BAR; PG8_WAIT_L(0); PG8_MMA(0, 0, At, B0); PG8_BAR; PG8_SCHED;
            PG8_LDB(B1, 1, 1); PG8_STAGE(PG8_SB(1, 0), b3, voffB);
            PG8_BAR; PG8_WAIT_L(0); PG8_MMA(0, 1, At, B1); PG8_BAR;
            PG8_LDA(At, 1, 1); PG8_STAGE(PG8_SA(1, 0), a3, voffA);
            PG8_BAR; PG8_WAIT_L(0); PG8_MMA(1, 0, At, B0); PG8_BAR; PG8_SCHED;
            PG8_STAGE(PG8_SB(1, 1), b3 + hstep, voffB);
            PG8_WAIT_V(6); PG8_BAR; PG8_MMA(1, 1, At, B1); PG8_BAR;
            }
        }
        if constexpr (ALIGN_EPI) { if (wr == 0) PG8_BAR; }
        if constexpr (!Epi::AFTER_DRAIN) { E(acc, cur, wr, wc, fr, fq, lds); S.done(cur); }
        if (!has_next) break;
#pragma unroll
        for (int a = 0; a < 2; ++a)
#pragma unroll
            for (int b = 0; b < 2; ++b)
#pragma unroll
                for (int m = 0; m < 4; ++m)
#pragma unroll
                    for (int n = 0; n < 2; ++n) acc[a][b][m][n] = (f32x4){0.f, 0.f, 0.f, 0.f};
        cur = nxt; cA = nA; cB = nB; ++ui;
        if constexpr (ALIGN_EPI) { if (wr == 1) PG8_BAR; }
    }
    PG8_WAIT_V(0);
    if constexpr (!ALIGN_EPI) { if (wr == 0) PG8_BAR; }
    PG8_BAR;
    if constexpr (Epi::AFTER_DRAIN) { E.fused(acc, cur, wr, wc, fr, fq, lds, wid, lane); S.done(cur); }
#undef PG8_SA
#undef PG8_SB
#undef PG8_STAGE
#undef PG8_LDA
#undef PG8_LDB
#undef PG8_MMA
#undef PG8_WAIT_V
#undef PG8_WAIT_L
#undef PG8_BAR
#undef PG8_SCHED
}
}
#define LAS __attribute__((address_space(3)))
typedef unsigned short bf16_t;
typedef short bf16x8 __attribute__((ext_vector_type(8)));
typedef float f32x4 __attribute__((ext_vector_type(4)));
typedef float f32x2 __attribute__((ext_vector_type(2)));
typedef unsigned u32x4 __attribute__((ext_vector_type(4)));
using pg8::cvt_pk_bf16;

constexpr int T_TOK = 65536, DM = 1024, SEQ = 2048, NBATCH = 32, DFF = 2816, ZW = 2560, MEMT = 8192;
constexpr float DN_ALPHA = 1.681792830507429f, LN_EPS = 1e-5f, LOG2E = 1.4426950408889634f;
constexpr size_t SZ_W1 = (size_t)5632 * 1024, SZ_W2 = (size_t)1024 * 2816;
constexpr size_t OFF_W1 = 0, OFF_W2 = 2 * SZ_W1, OFF_WQ = OFF_W2 + 2 * SZ_W2, OFF_WKV = OFF_WQ + 1048576, OFF_WO = OFF_WKV + 2097152,
                 OFF_WIN = OFF_WO + 1048576, OFF_WOUT = OFF_WIN + 2621440, OFF_WEX = OFF_WOUT + 1048576, LAYER_W = OFF_WEX + 524288;
static_assert(LAYER_W * 2 == (size_t)49 << 20, "layer weights = 49 MiB");
constexpr size_t MiB = 1u << 20;
constexpr size_t WS_STATS = 1016 * MiB, WS_CVEC = 198 * MiB, WS_ONES = 198 * MiB + 786432, WS_ZEROS = 198 * MiB + 790528, CVEC_STRIDE = 2 * 5632, WS_SPL = 1 * MiB + 917504, WS_ROPE_DA = 1 * MiB, WS_ROPE_RET = 1 * MiB + 131072, WS_W = 2 * MiB, WS_MEMB = 200 * MiB, WS_XB = 216 * MiB, WS_BIG = 344 * MiB,
                 WS_CAT = 696 * MiB, WS_AUX = 824 * MiB, WS_AUX2 = 952 * MiB, WS_END = 1024 * MiB;
constexpr int LDS_BYTES = 156160;

struct Params { const float* in[32]; float* out; unsigned char* ws; };

__device__ __forceinline__ float bflo(unsigned w) { return __uint_as_float(w << 16); }
__device__ __forceinline__ float bfhi(unsigned w) { return __uint_as_float(w & 0xffff0000u); }
__device__ __forceinline__ unsigned short f2bf(float f) { return (unsigned short)(cvt_pk_bf16(f, 0.f) & 0xffffu); }
__device__ __forceinline__ float gelu_tanh(float x) { const float t = 1.5957691216057308f * (x + 0.044715f * x * x * x); return x * __builtin_amdgcn_rcpf(1.0f + __expf(-t)); }
__device__ __forceinline__ float silu_f(float x) { return x * __builtin_amdgcn_rcpf(1.0f + __expf(-x)); }
#define WSYNC() asm volatile("s_waitcnt lgkmcnt(0)" ::: "memory")
__device__ __forceinline__ float wave_sum(float v) {
    int self = (int)__builtin_amdgcn_mbcnt_hi(~0u, __builtin_amdgcn_mbcnt_lo(~0u, 0u)); asm volatile("" : "+v"(self));
#pragma unroll
    for (int o = 1; o < 16; o <<= 1) v += __int_as_float(__builtin_amdgcn_ds_bpermute((self ^ o) << 2, __float_as_int(v)));
    return xsum_rows(v);
}
__device__ __forceinline__ float red16(float v) { v += __shfl_xor(v, 1); v += __shfl_xor(v, 2); v += __shfl_xor(v, 4); v += __shfl_xor(v, 8); return v; }
__device__ __forceinline__ float max16(float v) { v = fmaxf(v, __shfl_xor(v, 1)); v = fmaxf(v, __shfl_xor(v, 2)); v = fmaxf(v, __shfl_xor(v, 4)); v = fmaxf(v, __shfl_xor(v, 8)); return v; }
__device__ __forceinline__ void sincos_acc(float angf, float& s, float& c) {
    const double x = (double)angf; const double k = rint(x * 0.15915494309189535); const double r = fma(-k, 6.283185307179586, x);
    const double r2 = r * r; double ts = r, tc = 1.0, ss = r, cc = 1.0;
#pragma unroll
    for (int n = 1; n <= 14; ++n) { tc *= -r2 * (1.0 / (double)((2 * n - 1) * (2 * n))); cc += tc; ts *= -r2 * (1.0 / (double)((2 * n) * (2 * n + 1))); ss += ts; }
    s = (float)ss; c = (float)cc;
}

__device__ __forceinline__ void transpose_mat(const float* W, int K, int N, bf16_t* WT, int mode, int row_off, LAS float* scr, int gw, int NGW, int lane, int& base_item, const float* gs = nullptr) {
    const int nblk = N / 32, items = (K / 64) * nblk;
    int first = (gw - (base_item % NGW) + NGW) % NGW;
    for (int item = first; item < items; item += NGW) {
        const int kb = item / nblk, nb = item % nblk, k0 = 64 * kb, n0 = 32 * nb;
        const int rowbase = mode ? ((n0 >> 7) * 256 + row_off + (n0 & 127)) : (row_off + n0);
#pragma unroll
        for (int i = 0; i < 32; ++i) { const int kk = 2 * i + (lane >> 5); const float sc_ = gs ? gs[k0 + kk] : 1.0f; scr[kk * 33 + (lane & 31)] = W[(size_t)(k0 + kk) * N + n0 + (lane & 31)] * sc_; }
        WSYNC();
        const int c = lane & 7;
#pragma unroll
        for (int j = 0; j < 4; ++j) { const int n = (lane >> 3) + 8 * j; const LAS float* s = scr + (8 * c) * 33 + n;
            u32x4 o; o.x = cvt_pk_bf16(s[0 * 33], s[1 * 33]); o.y = cvt_pk_bf16(s[2 * 33], s[3 * 33]); o.z = cvt_pk_bf16(s[4 * 33], s[5 * 33]); o.w = cvt_pk_bf16(s[6 * 33], s[7 * 33]);
            *(u32x4*)(WT + (size_t)(rowbase + n) * K + k0 + 8 * c) = o; }
        WSYNC();
    }
    base_item += items;
}

typedef unsigned u32x2 __attribute__((ext_vector_type(2)));
template <int D, int DV, int MODE, int NMAP>
__device__ __forceinline__ void attn_core2(LAS unsigned char* lds, const bf16_t* Qp, int ldq, const bf16_t* Kp, int ldk, const bf16_t* Vp, int ldv,
                                           int q0, int nkt, float sc, float l2g, f32x4 (&o)[NMAP][DV / 16], float (&l)[NMAP]) {
    constexpr int DT = NMAP * D, KSTR = DT + 8, VSTR = 72, KS_BYTES = 64 * KSTR * 2, KN = DT / 64, VN = DV / 64;
    int tid_ = threadIdx.x; asm volatile("" : "+v"(tid_)); const int tid = tid_, lane = tid & 63, w = __builtin_amdgcn_readfirstlane(tid >> 6), r = lane & 15, g4 = lane >> 4;
    LAS bf16_t* Ks = (LAS bf16_t*)lds; LAS bf16_t* Vt = (LAS bf16_t*)(lds + KS_BYTES);
    bf16x8 qf[NMAP][D / 32];
    { const bf16_t* qr = Qp + (size_t)(w * 16 + r) * ldq + g4 * 8;
#pragma unroll
      for (int mp = 0; mp < NMAP; ++mp)
#pragma unroll
        for (int kk = 0; kk < D / 32; ++kk) qf[mp][kk] = *(const bf16x8*)(qr + mp * D + kk * 32); }
    float m[NMAP];
#pragma unroll
    for (int mp = 0; mp < NMAP; ++mp) { m[mp] = -INFINITY; l[mp] = 0.f;
#pragma unroll
        for (int cb = 0; cb < DV / 16; ++cb) o[mp][cb] = (f32x4){0.f, 0.f, 0.f, 0.f}; }
    const int rowmin = q0 + w * 16, myrow = rowmin + r;
    u32x4 kreg[KN], vreg[VN];
#pragma unroll
    for (int i = 0; i < KN; ++i) { const int c = tid + i * 512; const int key = c / (DT / 8), ch = c % (DT / 8); kreg[i] = *(const u32x4*)(Kp + (size_t)key * ldk + ch * 8); }
#pragma unroll
    for (int i = 0; i < VN; ++i) { const int c = w + i * 8; vreg[i] = *(const u32x4*)(Vp + (size_t)lane * ldv + c * 8); }
    for (int kt = 0; kt < nkt; ++kt) {
        __syncthreads();
#pragma unroll
        for (int i = 0; i < KN; ++i) { const int c = tid + i * 512; const int key = c / (DT / 8), ch = c % (DT / 8); *(LAS u32x4*)(Ks + key * KSTR + ch * 8) = kreg[i]; }
#pragma unroll
        for (int i = 0; i < VN; ++i) { const int c = w + i * 8; const u32x4 v = vreg[i];
            LAS bf16_t* d = Vt + (c * 8) * VSTR + lane;
            d[0 * VSTR] = (bf16_t)(v.x & 0xffffu); d[1 * VSTR] = (bf16_t)(v.x >> 16); d[2 * VSTR] = (bf16_t)(v.y & 0xffffu); d[3 * VSTR] = (bf16_t)(v.y >> 16);
            d[4 * VSTR] = (bf16_t)(v.z & 0xffffu); d[5 * VSTR] = (bf16_t)(v.z >> 16); d[6 * VSTR] = (bf16_t)(v.w & 0xffffu); d[7 * VSTR] = (bf16_t)(v.w >> 16); }
        __syncthreads();
        if (kt + 1 < nkt) {
#pragma unroll
            for (int i = 0; i < KN; ++i) { const int c = tid + i * 512; const int key = c / (DT / 8), ch = c % (DT / 8); kreg[i] = *(const u32x4*)(Kp + (size_t)((kt + 1) * 64 + key) * ldk + ch * 8); }
#pragma unroll
            for (int i = 0; i < VN; ++i) { const int c = w + i * 8; vreg[i] = *(const u32x4*)(Vp + (size_t)((kt + 1) * 64 + lane) * ldv + c * 8); }
        }
        if (MODE == 0 || kt * 64 <= rowmin + 15) {
            bf16x8 pb[NMAP][2];
#pragma unroll
            for (int mp = 0; mp < NMAP; ++mp) {
                f32x4 s[4];
#pragma unroll
                for (int nb = 0; nb < 4; ++nb) { s[nb] = (f32x4){0.f, 0.f, 0.f, 0.f};
#pragma unroll
                    for (int kk = 0; kk < D / 32; ++kk) { const bf16x8 kf = *(const LAS bf16x8*)(Ks + (nb * 16 + r) * KSTR + mp * D + kk * 32 + g4 * 8);
                        s[nb] = __builtin_amdgcn_mfma_f32_16x16x32_bf16(kf, qf[mp][kk], s[nb], 0, 0, 0); } }
                if (MODE < 2) {
                    float mx = -INFINITY;
#pragma unroll
                    for (int nb = 0; nb < 4; ++nb)
#pragma unroll
                        for (int j = 0; j < 4; ++j) { float x = s[nb][j] * sc;
                            if (MODE == 1) { const int key = kt * 64 + nb * 16 + g4 * 4 + j; if (key > myrow) x = -INFINITY; }
                            s[nb][j] = x; mx = fmaxf(mx, x); }
                    mx = xmax_rows(mx);
                    const float mn = fmaxf(m[mp], mx); const float al = __builtin_amdgcn_exp2f(m[mp] - mn); m[mp] = mn;
                    float ps = 0.f;
#pragma unroll
                    for (int nb = 0; nb < 4; ++nb)
#pragma unroll
                        for (int j = 0; j < 4; ++j) { const float p = __builtin_amdgcn_exp2f(s[nb][j] - mn); ps += p; s[nb][j] = p; }
                    l[mp] = l[mp] * al + ps;
#pragma unroll
                    for (int cb = 0; cb < DV / 16; ++cb) o[mp][cb] = o[mp][cb] * al;
                } else {
#pragma unroll
                    for (int nb = 0; nb < 4; ++nb)
#pragma unroll
                        for (int j = 0; j < 4; ++j) { const int dd = myrow - (kt * 64 + nb * 16 + g4 * 4 + j);
                            s[nb][j] = dd >= 0 ? s[nb][j] * __builtin_amdgcn_exp2f(l2g * (float)dd) : 0.f; }
                }
#pragma unroll
                for (int kk = 0; kk < 2; ++kk) { u32x4 wv; wv.x = cvt_pk_bf16(s[2 * kk][0], s[2 * kk][1]); wv.y = cvt_pk_bf16(s[2 * kk][2], s[2 * kk][3]);
                    wv.z = cvt_pk_bf16(s[2 * kk + 1][0], s[2 * kk + 1][1]); wv.w = cvt_pk_bf16(s[2 * kk + 1][2], s[2 * kk + 1][3]); pb[mp][kk] = __builtin_bit_cast(bf16x8, wv); }
            }
#pragma unroll
            for (int kk = 0; kk < 2; ++kk)
#pragma unroll
                for (int cb = 0; cb < DV / 16; ++cb) { const LAS bf16_t* vp = Vt + (cb * 16 + r) * VSTR + kk * 32 + g4 * 4;
                    const u32x2 lo = *(const LAS u32x2*)vp, hi = *(const LAS u32x2*)(vp + 16); u32x4 t; t.x = lo.x; t.y = lo.y; t.z = hi.x; t.w = hi.y;
                    const bf16x8 vf = __builtin_bit_cast(bf16x8, t);
#pragma unroll
                    for (int mp = 0; mp < NMAP; ++mp) o[mp][cb] = __builtin_amdgcn_mfma_f32_16x16x32_bf16(vf, pb[mp][kk], o[mp][cb], 0, 0, 0); }
        }
    }
    if (MODE < 2) {
#pragma unroll
        for (int mp = 0; mp < NMAP; ++mp) { l[mp] = xsum_rows(l[mp]); }
    }
}

template <int D, int DV, int MODE, int NMAP, int KT>
__device__ __forceinline__ void attn_core3(LAS unsigned char* lds, const bf16_t* Qp, int ldq, const bf16_t* Kp, int ldk, const bf16_t* Vp, int ldv,
                                           int q0, int nkt, float sc, float l2g, f32x4 (&o)[NMAP][DV / 16], float (&l)[NMAP]) {
    constexpr int DT = NMAP * D, KSTR = DT + 8, VSTR = KT + 8, KS_BYTES = KT * KSTR * 2, VT_BYTES = DV * VSTR * 2, BUF_BYTES = KS_BYTES + VT_BYTES, KN = KT * (DT / 8) / 512, VN = (DV / 8) * (KT / 64) / 8, NB = KT / 16, KK2 = KT / 32;
    int tid_ = threadIdx.x; asm volatile("" : "+v"(tid_)); const int tid = tid_, lane = tid & 63, w = __builtin_amdgcn_readfirstlane(tid >> 6), r = lane & 15, g4 = lane >> 4;
    bf16x8 qf[NMAP][D / 32];
    { const bf16_t* qr = Qp + (size_t)(w * 16 + r) * ldq + g4 * 8;
#pragma unroll
      for (int mp = 0; mp < NMAP; ++mp)
#pragma unroll
        for (int kk = 0; kk < D / 32; ++kk) qf[mp][kk] = *(const bf16x8*)(qr + mp * D + kk * 32); }
    float m[NMAP];
#pragma unroll
    for (int mp = 0; mp < NMAP; ++mp) { m[mp] = -INFINITY; l[mp] = 0.f;
#pragma unroll
        for (int cb = 0; cb < DV / 16; ++cb) o[mp][cb] = (f32x4){0.f, 0.f, 0.f, 0.f}; }
    const int rowmin = q0 + w * 16, myrow = rowmin + r;
    float ck[NB][4];
    if (MODE == 2) {
#pragma unroll
        for (int nb = 0; nb < NB; ++nb)
#pragma unroll
            for (int j = 0; j < 4; ++j) ck[nb][j] = __builtin_amdgcn_exp2f(-l2g * (float)(nb * 16 + g4 * 4 + j));
    }
    u32x4 kreg[KN], vreg[VN];
#define AT_LOAD(t) do { _Pragma("unroll") for (int i = 0; i < KN; ++i) { const int c = tid + i * 512; const int key = c / (DT / 8), ch = c % (DT / 8); kreg[i] = *(const u32x4*)(Kp + (size_t)((t) * KT + key) * ldk + ch * 8); } \
        _Pragma("unroll") for (int i = 0; i < VN; ++i) { const int it_ = w + i * 8; const int c = it_ % (DV / 8), kg = it_ / (DV / 8); vreg[i] = *(const u32x4*)(Vp + (size_t)((t) * KT + kg * 64 + lane) * ldv + c * 8); } } while (0)
#define AT_STORE(boff) do { LAS bf16_t* Ks_ = (LAS bf16_t*)(lds + (boff)); LAS bf16_t* Vt_ = (LAS bf16_t*)(lds + (boff) + KS_BYTES); \
        _Pragma("unroll") for (int i = 0; i < KN; ++i) { const int c = tid + i * 512; const int key = c / (DT / 8), ch = c % (DT / 8); *(LAS u32x4*)(Ks_ + key * KSTR + ch * 8) = kreg[i]; } \
        _Pragma("unroll") for (int i = 0; i < VN; ++i) { const int it_ = w + i * 8; const int c = it_ % (DV / 8), kg = it_ / (DV / 8); const u32x4 v = vreg[i]; LAS bf16_t* d = Vt_ + (c * 8) * VSTR + kg * 64 + lane; \
            d[0 * VSTR] = (bf16_t)(v.x & 0xffffu); d[1 * VSTR] = (bf16_t)(v.x >> 16); d[2 * VSTR] = (bf16_t)(v.y & 0xffffu); d[3 * VSTR] = (bf16_t)(v.y >> 16); \
            d[4 * VSTR] = (bf16_t)(v.z & 0xffffu); d[5 * VSTR] = (bf16_t)(v.z >> 16); d[6 * VSTR] = (bf16_t)(v.w & 0xffffu); d[7 * VSTR] = (bf16_t)(v.w >> 16); } } while (0)
    AT_LOAD(0);
    __syncthreads();
    AT_STORE(0);
    if (nkt > 1) AT_LOAD(1);
    for (int kt = 0; kt < nkt; ++kt) {
        __syncthreads();
        const int cur = (kt & 1) * BUF_BYTES;
        if (kt + 1 < nkt) { AT_STORE(((kt + 1) & 1) * BUF_BYTES); if (kt + 2 < nkt) AT_LOAD(kt + 2); }
        if (MODE == 0 || kt * KT <= rowmin + 15) {
            const LAS bf16_t* Ks = (const LAS bf16_t*)(lds + cur); const LAS bf16_t* Vt = (const LAS bf16_t*)(lds + cur + KS_BYTES);
            const bool diag = (MODE != 0) && (kt * KT + KT - 1 > rowmin);
            bf16x8 pb[NMAP][KK2];
            f32x4 sall[NMAP][NB];
#pragma unroll
            for (int mp = 0; mp < NMAP; ++mp) {
                f32x4 (&s)[NB] = sall[mp];
                constexpr int KD = D / 32, NBB = (KD >= 8) ? 1 : (8 / KD), NSB = NB / NBB;
                bf16x8 kfr[2][NBB][KD];
#define AT_SLOAD(bi_, sl_) do { _Pragma("unroll") for (int x_ = 0; x_ < NBB; ++x_) _Pragma("unroll") for (int kk = 0; kk < KD; ++kk) \
                    kfr[sl_][x_][kk] = *(const LAS bf16x8*)(Ks + (((bi_) * NBB + x_) * 16 + r) * KSTR + mp * D + kk * 32 + g4 * 8); } while (0)
                AT_SLOAD(0, 0);
#pragma unroll
                for (int bi = 0; bi < NSB; ++bi) {
                    if (bi + 1 < NSB) AT_SLOAD(bi + 1, (bi + 1) & 1);
                    __builtin_amdgcn_sched_barrier(0);
                    __builtin_amdgcn_s_setprio(1);
#pragma unroll
                    for (int x_ = 0; x_ < NBB; ++x_) { const int nb = bi * NBB + x_;
                        s[nb] = __builtin_amdgcn_mfma_f32_16x16x32_bf16(kfr[bi & 1][x_][0], qf[mp][0], (f32x4){0.f, 0.f, 0.f, 0.f}, 0, 0, 0);
#pragma unroll
                        for (int kk = 1; kk < KD; ++kk) s[nb] = __builtin_amdgcn_mfma_f32_16x16x32_bf16(kfr[bi & 1][x_][kk], qf[mp][kk], s[nb], 0, 0, 0); }
                    __builtin_amdgcn_s_setprio(0);
                    __builtin_amdgcn_sched_barrier(0);
                }
#undef AT_SLOAD
            }
#pragma unroll
            for (int mp = 0; mp < NMAP; ++mp) {
                f32x4 (&s)[NB] = sall[mp];
                if (MODE < 2) {
                    if (diag) {
#pragma unroll
                        for (int nb = 0; nb < NB; ++nb)
#pragma unroll
                            for (int j = 0; j < 4; ++j) { if (kt * KT + nb * 16 + g4 * 4 + j > myrow) s[nb][j] = -INFINITY; }
                    }
                    float mx = fmaxf(fmaxf(s[0][0], s[0][1]), s[0][2]);
                    mx = fmaxf(fmaxf(mx, s[0][3]), s[1][0]); mx = fmaxf(fmaxf(mx, s[1][1]), s[1][2]); mx = fmaxf(fmaxf(mx, s[1][3]), s[2][0]);
                    mx = fmaxf(fmaxf(mx, s[2][1]), s[2][2]); mx = fmaxf(fmaxf(mx, s[2][3]), s[3][0]); mx = fmaxf(fmaxf(mx, s[3][1]), s[3][2]); mx = fmaxf(mx, s[3][3]);
#pragma unroll
                    for (int nb = 4; nb < NB; ++nb) { mx = fmaxf(fmaxf(mx, s[nb][0]), s[nb][1]); mx = fmaxf(fmaxf(mx, s[nb][2]), s[nb][3]); }
                    mx = xmax_rows(mx) * sc;
                    if (__any(mx > m[mp] + 6.0f)) {
                        const float mn = fmaxf(m[mp], mx); const float al = __builtin_amdgcn_exp2f(m[mp] - mn); m[mp] = mn; l[mp] *= al;
#pragma unroll
                        for (int cb = 0; cb < DV / 16; ++cb) o[mp][cb] = o[mp][cb] * al;
                    }
                    const float nm = -m[mp]; float ps = 0.f;
#pragma unroll
                    for (int nb = 0; nb < NB; ++nb)
#pragma unroll
                        for (int j = 0; j < 4; ++j) { const float p = __builtin_amdgcn_exp2f(fmaf(s[nb][j], sc, nm)); ps += p; s[nb][j] = p; }
                    l[mp] += ps;
                } else {
                    const float rowf = __builtin_amdgcn_exp2f(l2g * (float)(myrow - kt * KT));
#pragma unroll
                    for (int nb = 0; nb < NB; ++nb)
#pragma unroll
                        for (int j = 0; j < 4; ++j) { float p = s[nb][j] * (rowf * ck[nb][j]); if (diag && (kt * KT + nb * 16 + g4 * 4 + j > myrow)) p = 0.f; s[nb][j] = p; }
                }
#pragma unroll
                for (int kk = 0; kk < KK2; ++kk) { u32x4 wv; wv.x = cvt_pk_bf16(s[2 * kk][0], s[2 * kk][1]); wv.y = cvt_pk_bf16(s[2 * kk][2], s[2 * kk][3]);
                    wv.z = cvt_pk_bf16(s[2 * kk + 1][0], s[2 * kk + 1][1]); wv.w = cvt_pk_bf16(s[2 * kk + 1][2], s[2 * kk + 1][3]); pb[mp][kk] = __builtin_bit_cast(bf16x8, wv); }
            }
            {
                constexpr int CBB = 4, NCB = (DV / 16) / CBB, NVB = KK2 * NCB;
                bf16x8 vfr[2][CBB];
#define AT_VLOAD(b_, sl_) do { const int kk_ = (b_) / NCB, c0_ = ((b_) % NCB) * CBB; _Pragma("unroll") for (int x_ = 0; x_ < CBB; ++x_) { const LAS bf16_t* vp = Vt + ((c0_ + x_) * 16 + r) * VSTR + kk_ * 32 + g4 * 4; \
                    const u32x2 lo = *(const LAS u32x2*)vp, hi = *(const LAS u32x2*)(vp + 16); u32x4 t; t.x = lo.x; t.y = lo.y; t.z = hi.x; t.w = hi.y; vfr[sl_][x_] = __builtin_bit_cast(bf16x8, t); } } while (0)
                AT_VLOAD(0, 0);
#pragma unroll
                for (int b_ = 0; b_ < NVB; ++b_) {
                    if (b_ + 1 < NVB) AT_VLOAD(b_ + 1, (b_ + 1) & 1);
                    __builtin_amdgcn_sched_barrier(0);
                    const int kk_ = b_ / NCB, c0_ = (b_ % NCB) * CBB;
                    __builtin_amdgcn_s_setprio(1);
#pragma unroll
                    for (int x_ = 0; x_ < CBB; ++x_)
#pragma unroll
                        for (int mp = 0; mp < NMAP; ++mp) o[mp][c0_ + x_] = __builtin_amdgcn_mfma_f32_16x16x32_bf16(vfr[b_ & 1][x_], pb[mp][kk_], o[mp][c0_ + x_], 0, 0, 0);
                    __builtin_amdgcn_s_setprio(0);
                    __builtin_amdgcn_sched_barrier(0);
                }
#undef AT_VLOAD
            }
        }
    }
#undef AT_LOAD
#undef AT_STORE
    if (MODE < 2) {
#pragma unroll
        for (int mp = 0; mp < NMAP; ++mp) l[mp] = xsum_rows(l[mp]);
    }
}
constexpr int S5_LDS_WAVE = 28160;
__device__ __forceinline__ void s5_unit(LAS unsigned char* lw, int b, int g, const float* lam_re, const float* lam_im, const float* log_step,
                                        const float* b_re, const float* b_im, const float* c_re, const float* c_im, const float* d_skip,
                                        const bf16_t* Z, bf16_t* Z5, int lane) {
    const int n = lane, r = lane & 15, g4 = lane >> 4;
    LAS float* U = (LAS float*)lw; LAS bf16_t* H = (LAS bf16_t*)(lw + 2048); LAS float* Xs = (LAS float*)(lw + 2048 + 8704); LAS f32x2* Fs = (LAS f32x2*)(lw + 2048 + 8704 + 16896);
    const float step = expf(log_step[g]); const float lr = fminf(lam_re[g * 64 + n], -1e-4f), li = lam_im[g * 64 + n];
    const float mag = expf(lr * step); float sn, cs; sincos_acc(li * step, sn, cs);
    const float are = mag * cs, aim = mag * sn;
    { const float den = lr * lr + li * li, nr = are - 1.0f, ni = aim; Fs[n] = (f32x2){(nr * lr + ni * li) / den, (ni * lr - nr * li) / den}; }
    WSYNC();
    bf16x8 Bf[8];
#pragma unroll
    for (int nb = 0; nb < 8; ++nb) {
        const int ns = (nb & 3) * 16 + r; const f32x2 f = Fs[ns];
        u32x4 wv = (u32x4){0u, 0u, 0u, 0u};
        if (g4 < 2) {
            const f32x4 br0 = *(const f32x4*)(b_re + (size_t)(g * 64 + ns) * 16 + g4 * 8), br1 = *(const f32x4*)(b_re + (size_t)(g * 64 + ns) * 16 + g4 * 8 + 4);
            const f32x4 bi0 = *(const f32x4*)(b_im + (size_t)(g * 64 + ns) * 16 + g4 * 8), bi1 = *(const f32x4*)(b_im + (size_t)(g * 64 + ns) * 16 + g4 * 8 + 4);
            f32x4 v0, v1;
            if (nb < 4) { v0 = br0 * f.x - bi0 * f.y; v1 = br1 * f.x - bi1 * f.y; } else { v0 = bi0 * f.x + br0 * f.y; v1 = bi1 * f.x + br1 * f.y; }
            wv.x = cvt_pk_bf16(v0[0], v0[1]); wv.y = cvt_pk_bf16(v0[2], v0[3]); wv.z = cvt_pk_bf16(v1[0], v1[1]); wv.w = cvt_pk_bf16(v1[2], v1[3]);
        }
        Bf[nb] = __builtin_bit_cast(bf16x8, wv);
    }
    bf16x8 CfT[4];
#pragma unroll
    for (int kk = 0; kk < 4; ++kk)
#pragma unroll
        for (int e = 0; e < 8; ++e) { const int kf_ = kk * 32 + g4 * 8 + e, n_ = kf_ >> 1;
            const float v = (kf_ & 1) ? -c_im[(size_t)(g * 16 + r) * 64 + n_] : c_re[(size_t)(g * 16 + r) * 64 + n_];
            CfT[kk][e] = (short)f2bf(v); }
    const f32x4 dsk4 = *(const f32x4*)(d_skip + g * 16 + g4 * 4);
    float hr = 0.f, hi = 0.f;
    const bf16_t* zb = Z + (size_t)b * SEQ * ZW + g * 16;
    bf16_t* ob = Z5 + (size_t)b * SEQ * 512 + g * 16;
    const int g4c = g4 < 2 ? g4 : 0;
    u32x4 vnext = *(const u32x4*)(zb + (size_t)(lane >> 1) * ZW + (lane & 1) * 8);
    u32x4 an0 = *(const u32x4*)(zb + (size_t)r * ZW + g4c * 8), an1 = *(const u32x4*)(zb + (size_t)(16 + r) * ZW + g4c * 8);
    for (int tc = 0; tc < SEQ / 32; ++tc) {
        const int t0 = tc * 32;
        u32x4 a0 = an0, a1 = an1; if (g4 >= 2) { a0 = (u32x4){0u, 0u, 0u, 0u}; a1 = a0; }
        { const int tk = lane >> 1, hf = lane & 1; const u32x4 v = vnext;
          if (tc + 1 < SEQ / 32) { vnext = *(const u32x4*)(zb + (size_t)(t0 + 32 + tk) * ZW + hf * 8);
              an0 = *(const u32x4*)(zb + (size_t)(t0 + 32 + r) * ZW + g4c * 8); an1 = *(const u32x4*)(zb + (size_t)(t0 + 48 + r) * ZW + g4c * 8); }
          f32x4 a, c2; a[0] = bflo(v.x); a[1] = bfhi(v.x); a[2] = bflo(v.y); a[3] = bfhi(v.y); c2[0] = bflo(v.z); c2[1] = bfhi(v.z); c2[2] = bflo(v.w); c2[3] = bfhi(v.w);
          *(LAS f32x4*)(U + tk * 16 + hf * 8) = a; *(LAS f32x4*)(U + tk * 16 + hf * 8 + 4) = c2; }
#pragma unroll
        for (int rb = 0; rb < 2; ++rb) { const bf16x8 af = __builtin_bit_cast(bf16x8, rb ? a1 : a0);
#pragma unroll
            for (int nb = 0; nb < 8; ++nb) { const f32x4 xa = __builtin_amdgcn_mfma_f32_16x16x32_bf16(Bf[nb], af, (f32x4){0.f, 0.f, 0.f, 0.f}, 0, 0, 0);
                *(LAS f32x4*)(Xs + (rb * 16 + r) * 132 + nb * 16 + g4 * 4) = xa; } }
        WSYNC();
        {
            float xrv[32], xiv[32]; unsigned hp[32];
#pragma unroll
            for (int t = 0; t < 32; ++t) { xrv[t] = Xs[t * 132 + n]; xiv[t] = Xs[t * 132 + 64 + n]; }
            __builtin_amdgcn_sched_barrier(0);
#pragma unroll
            for (int t = 0; t < 32; ++t) { const float nhr = are * hr - aim * hi + xrv[t], nhi = are * hi + aim * hr + xiv[t]; hr = nhr; hi = nhi; hp[t] = cvt_pk_bf16(hr, hi); }
            __builtin_amdgcn_sched_barrier(0);
#pragma unroll
            for (int t = 0; t < 32; ++t) *(LAS unsigned*)(H + t * 136 + 2 * n) = hp[t];
        }
        WSYNC();
        {
            bf16x8 hf[2][4]; f32x4 uu[2];
#pragma unroll
            for (int rb = 0; rb < 2; ++rb) {
#pragma unroll
                for (int kk = 0; kk < 4; ++kk) hf[rb][kk] = *(const LAS bf16x8*)(H + (rb * 16 + r) * 136 + kk * 32 + g4 * 8);
                uu[rb] = *(const LAS f32x4*)(U + (rb * 16 + r) * 16 + g4 * 4); }
            __builtin_amdgcn_sched_barrier(0);
#pragma unroll
            for (int rb = 0; rb < 2; ++rb) {
                f32x4 acc = __builtin_amdgcn_mfma_f32_16x16x32_bf16(CfT[0], hf[rb][0], (f32x4){0.f, 0.f, 0.f, 0.f}, 0, 0, 0);
#pragma unroll
                for (int kk = 1; kk < 4; ++kk) acc = __builtin_amdgcn_mfma_f32_16x16x32_bf16(CfT[kk], hf[rb][kk], acc, 0, 0, 0);
                const f32x4 y = acc + dsk4 * uu[rb];
                u32x2 ow; ow.x = cvt_pk_bf16(gelu_tanh(y[0]), gelu_tanh(y[1])); ow.y = cvt_pk_bf16(gelu_tanh(y[2]), gelu_tanh(y[3]));
                *(u32x2*)(ob + (size_t)(t0 + rb * 16 + r) * 512 + g4 * 4) = ow;
            }
        }
        WSYNC();
    }
}

#define RLX_AGENT __ATOMIC_RELAXED, __HIP_MEMORY_SCOPE_AGENT
#define XB_TMO      128
#define XB_XCNT(j)  (256  + 64 * (j))
#define XB_XSUB(j)  (1280 + 64 * (j))
#define XB_XGEN(j)  (2304 + 64 * (j))
#define XB_TOP      3328
#define XB_TOPGEN   3392
#define XCD_BAR_WORDS 3456
#define XB_SPIN_CAP (1u << 18)

__device__ __forceinline__ unsigned xb_ld(unsigned* p)              { return __hip_atomic_load(p, __ATOMIC_RELAXED, __HIP_MEMORY_SCOPE_AGENT); }
__device__ __forceinline__ unsigned xb_add(unsigned* p, unsigned v) { return __hip_atomic_fetch_add(p, v, __ATOMIC_RELAXED, __HIP_MEMORY_SCOPE_AGENT); }
__device__ __forceinline__ unsigned xb_xcc_id() { return (unsigned)__builtin_amdgcn_s_getreg((3 << 11) | 20) & 0xFu; }
#define XB_SPIN(cond, bar) do { unsigned _sp = 0; while (cond) { __builtin_amdgcn_s_sleep(1); \
    if ((++_sp & 255u) == 0u) { if (xb_ld(&(bar)[XB_TMO])) break; if (_sp > XB_SPIN_CAP) { atomicAdd(&(bar)[XB_TMO], 1u); break; } } } } while (0)

struct XcdBarrier {
    unsigned* bar; unsigned x;
    volatile LAS unsigned* st;
};

__device__ __forceinline__ XcdBarrier xcd_barrier_post(unsigned* bar, volatile LAS unsigned* st) {
    XcdBarrier b; b.bar = bar; b.x = xb_xcc_id(); b.st = st;
    if (threadIdx.x == 0) (void)xb_add(&bar[XB_XCNT(b.x)], 1u);
    return b;
}
__device__ __forceinline__ void xcd_barrier_complete(unsigned* bar, unsigned x, unsigned& nloc, unsigned& nx) {
    const unsigned G = gridDim.x * gridDim.y * gridDim.z;
    unsigned sum, cnt, mine, sp = 0u;
    for (;;) {
        sum = 0u; cnt = 0u; mine = 0u;
#pragma unroll
        for (unsigned j = 0; j < 16; ++j) { const unsigned c = xb_ld(&bar[XB_XCNT(j)]); sum += c; cnt += (c > 0u) ? 1u : 0u; mine = (j == x) ? c : mine; }
        if (sum == G) break;
        __builtin_amdgcn_s_sleep(1);
        if ((++sp & 255u) == 0u) { if (xb_ld(&bar[XB_TMO])) break; if (sp > XB_SPIN_CAP) { atomicAdd(&bar[XB_TMO], 1u); break; } }
    }
    nloc = mine > 0u ? mine : 1u; nx = cnt > 0u ? cnt : 1u;
}

__device__ __forceinline__ void xcd_barrier(const XcdBarrier& b) {
    asm volatile("s_waitcnt vmcnt(0)" ::: "memory");
    __syncthreads();
    if (threadIdx.x == 0) {
        unsigned* bar = b.bar;
        __builtin_amdgcn_s_waitcnt(0);
        unsigned nloc = b.st[0], nx = b.st[1];
        if (nloc == 0u) { xcd_barrier_complete(bar, b.x, nloc, nx); b.st[0] = nloc; b.st[1] = nx; }
        const unsigned old = xb_add(&bar[XB_XSUB(b.x)], 1u);
        const unsigned gen = old / nloc;
        if (old + 1u == (gen + 1u) * nloc) {
            __builtin_amdgcn_fence(__ATOMIC_RELEASE, "agent");
            asm volatile("s_waitcnt vmcnt(0)" ::: "memory");
            const unsigned og = xb_add(&bar[XB_TOP], 1u);
            const unsigned tg = og / nx;
            if (og + 1u == (tg + 1u) * nx) xb_add(&bar[XB_TOPGEN], 1u);
            else XB_SPIN(xb_ld(&bar[XB_TOPGEN]) == tg, bar);
            __builtin_amdgcn_fence(__ATOMIC_ACQUIRE, "agent");
            xb_add(&bar[XB_XGEN(b.x)], 1u);
            asm volatile("s_waitcnt vmcnt(0)" ::: "memory");
        } else {
            XB_SPIN(xb_ld(&bar[XB_XGEN(b.x)]) == gen, bar);
            __builtin_amdgcn_fence(__ATOMIC_ACQUIRE, "agent");
            asm volatile("s_waitcnt vmcnt(0)" ::: "memory");
        }
    }
    __syncthreads();
}

__device__ __forceinline__ void xcd_barrier_fast(const XcdBarrier& b) {
    asm volatile("s_waitcnt vmcnt(0)" ::: "memory");
    __syncthreads();
    if (threadIdx.x == 0) {
        unsigned* bar = b.bar;
        __builtin_amdgcn_s_waitcnt(0);
        unsigned nloc = b.st[0], nx = b.st[1];
        const unsigned old = xb_add(&bar[XB_XSUB(b.x)], 1u);
        const unsigned gen = old / nloc;
        if (old + 1u == (gen + 1u) * nloc) {
            __builtin_amdgcn_fence(__ATOMIC_RELEASE, "agent");
            asm volatile("s_waitcnt vmcnt(0)" ::: "memory");
            const unsigned og = xb_add(&bar[XB_TOP], 1u);
            const unsigned tg = og / nx;
            if (og + 1u == (tg + 1u) * nx) xb_add(&bar[XB_TOPGEN], 1u);
            else XB_SPIN(xb_ld(&bar[XB_TOPGEN]) == tg, bar);
            __builtin_amdgcn_fence(__ATOMIC_ACQUIRE, "agent");
            xb_add(&bar[XB_XGEN(b.x)], 1u);
            asm volatile("s_waitcnt vmcnt(0)" ::: "memory");
        } else {
            XB_SPIN(xb_ld(&bar[XB_XGEN(b.x)]) == gen, bar);
            __builtin_amdgcn_fence(__ATOMIC_ACQUIRE, "agent");
            asm volatile("s_waitcnt vmcnt(0)" ::: "memory");
        }
    }
    __syncthreads();
}

__global__ void __launch_bounds__(512, 2) mega_fwd(Params P) {
    extern __shared__ __attribute__((aligned(16))) unsigned char lds_raw[];
    cg::grid_group grid = cg::this_grid();
    LAS unsigned char* lds = (LAS unsigned char*)lds_raw;
    volatile LAS unsigned* bst = (volatile LAS unsigned*)(lds + 156144);
    if (threadIdx.x < 2) bst[threadIdx.x] = 0u;
    __syncthreads();
    (void)xcd_barrier_post((unsigned*)P.ws, bst);
#define GRID_BAR() do { XcdBarrier b_; b_.bar = (unsigned*)P.ws; b_.x = xb_xcc_id(); b_.st = (volatile LAS unsigned*)(lds + 156144); xcd_barrier_fast(b_); } while (0)
#define PHASE_IDS() int tid_ = threadIdx.x; asm volatile("" : "+v"(tid_)); const int tid = tid_, lane = tid & 63, wave = __builtin_amdgcn_readfirstlane(tid >> 6); \
    int G_ = gridDim.x, blk_ = blockIdx.x; asm volatile("" : "+s"(G_), "+s"(blk_)); const int G = G_, blk = blk_, gw = blk * 8 + wave, NGW = G * 8; \
    const size_t gtid = (size_t)blk * 512 + tid, GT = (size_t)G * 512; (void)lane; (void)gw; (void)NGW; (void)gtid; (void)GT; \
    unsigned char* ws = P.ws; float* X = P.out; asm volatile("" : "+s"(ws), "+s"(X)); \
    f32x2* ROPE_DA = (f32x2*)(ws + WS_ROPE_DA); f32x2* ROPE_RET = (f32x2*)(ws + WS_ROPE_RET); \
    bf16_t* W = (bf16_t*)(ws + WS_W); bf16_t* MEMB = (bf16_t*)(ws + WS_MEMB); bf16_t* XB = (bf16_t*)(ws + WS_XB); \
    bf16_t* BIG = (bf16_t*)(ws + WS_BIG); bf16_t* CAT = (bf16_t*)(ws + WS_CAT); \
    unsigned* AB = (unsigned*)(ws + WS_AUX); bf16_t* XC = (bf16_t*)(ws + WS_AUX2); bf16_t* Z5 = (bf16_t*)(ws + WS_AUX); bf16_t* KV = (bf16_t*)(ws + WS_AUX); \
    (void)X; (void)ROPE_DA; (void)ROPE_RET; (void)W; (void)MEMB; (void)XB; (void)BIG; (void)CAT; (void)AB; (void)XC; (void)Z5; (void)KV; \
    int l = lcur; asm volatile("" : "+s"(l)); const bf16_t* Wl = W + (size_t)l * LAYER_W; const int hl = l >> 1; bf16_t* Z = BIG; (void)Wl; (void)hl; (void)Z;
#define LN_CTX() const int kcur = l * 4 + si_; float* Scur = (float*)(ws + WS_STATS) + (size_t)(kcur & 1) * 524288; float* Snxt = (float*)(ws + WS_STATS) + (size_t)((kcur + 1) & 1) * 524288; \
    const float* cvk = (const float*)(ws + WS_CVEC) + (size_t)kcur * CVEC_STRIDE; (void)Scur; (void)Snxt; (void)cvk;
#define ZERO_SNXT()
    int lcur = 0;

    {
        PHASE_IDS();
        LAS float* scr = (LAS float*)(lds + wave * 16384);
        int base_item = 0;
        for (int l = 0; l < 4; ++l) {
            bf16_t* Wl = W + (size_t)l * LAYER_W;
            for (int s = 0; s < 2; ++s) {
                const size_t wi = (size_t)(l * 2 + s) * 1024 * 2816;
                const int kq = l * 4 + (s ? 3 : 0);
                const float* gs1 = kq ? P.in[2] + (size_t)(kq - 1) * 1024 : nullptr;
                transpose_mat(P.in[4] + wi, 1024, 2816, Wl + OFF_W1 + s * SZ_W1, 1, 0, scr, gw, NGW, lane, base_item, gs1);
                transpose_mat(P.in[5] + wi, 1024, 2816, Wl + OFF_W1 + s * SZ_W1, 1, 128, scr, gw, NGW, lane, base_item, gs1);
                transpose_mat(P.in[6] + wi, 2816, 1024, Wl + OFF_W2 + s * SZ_W2, 0, 0, scr, gw, NGW, lane, base_item);
            }
            transpose_mat(P.in[7] + (size_t)l * 1048576, 1024, 1024, Wl + OFF_WQ, 0, 0, scr, gw, NGW, lane, base_item, P.in[2] + (size_t)(l * 4 + 1) * 1024);
            transpose_mat(P.in[8] + (size_t)l * 2097152, 1024, 2048, Wl + OFF_WKV, 0, 0, scr, gw, NGW, lane, base_item);
            transpose_mat(P.in[9] + (size_t)l * 1048576, 1024, 1024, Wl + OFF_WO, 0, 0, scr, gw, NGW, lane, base_item);
            const int h = l >> 1;
            if (l & 1) transpose_mat(P.in[19] + (size_t)h * 2097152, 1024, 2048, Wl + OFF_WIN, 0, 0, scr, gw, NGW, lane, base_item, P.in[2] + (size_t)(l * 4) * 1024);
            else transpose_mat(P.in[10] + (size_t)h * 2621440, 1024, 2560, Wl + OFF_WIN, 0, 0, scr, gw, NGW, lane, base_item, P.in[2] + (size_t)(l * 4) * 1024);
            transpose_mat(((l & 1) ? P.in[20] : P.in[11]) + (size_t)h * 1048576, 1024, 1024, Wl + OFF_WOUT, 0, 0, scr, gw, NGW, lane, base_item);
            if (l & 1) transpose_mat(P.in[29] + (size_t)h * 262144, 512, 512, Wl + OFF_WEX, 0, 0, scr, gw, NGW, lane, base_item);
            else {
                const float* gwt = P.in[16] + (size_t)h * 2 * 8 * 64 * 64;
                bf16_t* dst = Wl + OFF_WEX;
                for (size_t i = gtid; i < (size_t)1024 * 512; i += GT) { const int row = (int)(i >> 9), k = (int)(i & 511);
                    const int pn = row >> 8, gsel = (row >> 7) & 1, ch = pn * 128 + (row & 127);
                    float v = 0.f; if ((k >> 6) == (ch >> 6)) v = gwt[(((size_t)gsel * 8 + (ch >> 6)) * 64 + (k & 63)) * 64 + (ch & 63)];
                    dst[i] = f2bf(v); }
            }
        }
        for (size_t wv_ = gtid >> 6; wv_ * 32 < (size_t)4 * 14848; wv_ += GT >> 6) {
            const size_t idx = wv_ * 32 + (lane & 31); const int kseg = (lane >> 5) * 512;
            const int l = (int)(idx / 14848); int rem = (int)(idx % 14848); const int h = l >> 1;
            int k; const float* Wp; int N, n, drow;
            if (rem < 5632) { k = l * 4; const int half = rem / 2816; n = rem % 2816; Wp = (half ? P.in[5] : P.in[4]) + (size_t)(l * 2) * 1024 * 2816; N = 2816; drow = (n >> 7) * 256 + half * 128 + (n & 127); }
            else if (rem < 8192) { rem -= 5632; k = l * 4 + 1; n = rem; N = (l & 1) ? 2048 : 2560; Wp = (l & 1) ? P.in[19] + (size_t)h * 2097152 : P.in[10] + (size_t)h * 2621440; drow = n; }
            else if (rem < 9216) { rem -= 8192; k = l * 4 + 2; n = rem; N = 1024; Wp = P.in[7] + (size_t)l * 1048576; drow = n; }
            else { rem -= 9216; k = l * 4 + 3; const int half = rem / 2816; n = rem % 2816; Wp = (half ? P.in[5] : P.in[4]) + (size_t)(l * 2 + 1) * 1024 * 2816; N = 2816; drow = (n >> 7) * 256 + half * 128 + (n & 127); }
            if (n < N) {
                float s1 = 0.f, s2 = 0.f;
                if (k == 0) {
#pragma unroll 16
                    for (int kk = kseg; kk < kseg + 512; ++kk) s1 += Wp[(size_t)kk * N + n];
                } else {
                    const float* gq = P.in[2] + (size_t)(k - 1) * 1024; const float* bq = P.in[3] + (size_t)(k - 1) * 1024;
#pragma unroll 16
                    for (int kk = kseg; kk < kseg + 512; ++kk) { const float wv = Wp[(size_t)kk * N + n]; s1 += gq[kk] * wv; s2 += bq[kk] * wv; }
                }
                s1 = xsum32(s1); s2 = xsum32(s2);
                if (kseg == 0) { float* cv = (float*)(ws + WS_CVEC) + (size_t)k * CVEC_STRIDE; cv[drow] = s1; cv[5632 + drow] = s2; }
            }
        }
        for (size_t i = gtid; i < 1024; i += GT) { ((float*)(ws + WS_ONES))[i] = 1.0f; ((float*)(ws + WS_ZEROS))[i] = 0.0f; }
        for (size_t i = gtid; i < (size_t)T_TOK * 4; i += GT) { ((f32x2*)(ws + WS_STATS))[i] = (f32x2){0.f, (i & 3) ? 0.f : 1024.0f * (1.0f - 1e-5f)}; }
        for (size_t i = gtid; i < 1024; i += GT) { const float L = P.in[18][i]; ((float*)(ws + WS_SPL))[i] = -8.0f * (fmaxf(-L, 0.f) + log1pf(expf(-fabsf(L)))); }
        for (size_t i0 = gtid; i0 < (size_t)MEMT * DM / 4; i0 += GT * 4) {
            f32x4 vv[4];
#pragma unroll
            for (int q = 0; q < 4; ++q) { const size_t i = i0 + (size_t)q * GT; vv[q] = (i < (size_t)MEMT * DM / 4) ? ((const f32x4*)P.in[1])[i] : (f32x4){0.f, 0.f, 0.f, 0.f}; }
#pragma unroll
            for (int q = 0; q < 4; ++q) { const size_t i = i0 + (size_t)q * GT; if (i < (size_t)MEMT * DM / 4) { const f32x4 v = vv[q];
                ((unsigned long long*)MEMB)[i] = (unsigned long long)cvt_pk_bf16(v[0], v[1]) | ((unsigned long long)cvt_pk_bf16(v[2], v[3]) << 32); } }
        }
        for (size_t i0 = gtid; i0 < (size_t)T_TOK * DM / 4; i0 += GT * 8) {
            f32x4 vv[8];
#pragma unroll
            for (int q = 0; q < 8; ++q) { const size_t i = i0 + (size_t)q * GT; vv[q] = (i < (size_t)T_TOK * DM / 4) ? ((const f32x4*)P.in[0])[i] : (f32x4){0.f, 0.f, 0.f, 0.f}; }
#pragma unroll
            for (int q = 0; q < 8; ++q) { const size_t i = i0 + (size_t)q * GT; if (i < (size_t)T_TOK * DM / 4) { const f32x4 v = vv[q];
                const unsigned h0 = cvt_pk_bf16(v[0], v[1]), h1 = cvt_pk_bf16(v[2], v[3]);
                const unsigned l0 = cvt_pk_bf16(v[0] - bflo(h0), v[1] - bfhi(h0)), l1 = cvt_pk_bf16(v[2] - bflo(h1), v[3] - bfhi(h1));
                ((unsigned long long*)XB)[i] = (unsigned long long)h0 | ((unsigned long long)h1 << 32);
                const size_t row = i >> 8, c4 = i & 255;
                ((unsigned long long*)X)[row * 512 + 256 + c4] = (unsigned long long)l0 | ((unsigned long long)l1 << 32); } }
        }
        for (size_t i = gtid; i < (size_t)SEQ * 40; i += GT) { const int pos = (int)(i / 40), e = (int)(i % 40);
            float inv; if (e < 8) inv = (float)exp2(-((double)e * 2.0 / 16.0) * 18.931568569324174);
            else inv = (float)exp2(-((double)(e - 8) * 2.0 / 64.0) * 13.287712379549449);
            const float ang = (float)pos * inv; float s, c; sincos_acc(ang, s, c);
            if (e < 8) ROPE_DA[pos * 8 + e] = (f32x2){c, s}; else ROPE_RET[pos * 32 + (e - 8)] = (f32x2){c, s}; }
    }
    __syncthreads();
    grid.sync();
    { XcdBarrier b_; b_.bar = (unsigned*)P.ws; b_.x = xb_xcc_id(); b_.st = (volatile LAS unsigned*)(lds + 156144); xcd_barrier(b_); }

    for (lcur = 0; lcur < 4; ++lcur) {
        const bool odd = (lcur & 1) != 0;
        for (int si = 0; si < 4; ++si) {
            int asel; size_t boff; int Kres; float sres;
            if (si == 0 || si == 3) {
                const int s = (si == 0) ? 0 : 1;
                { PHASE_IDS(); int si_ = si; asm volatile("" : "+s"(si_)); LN_CTX(); ZERO_SNXT(); pg8::Gemm g{XB, Wl + OFF_W1 + s * SZ_W1, T_TOK, 5632, 1024}; pg8::StaticOrder S; S.init(T_TOK, 5632, G, blk);
                  { LAS unsigned* CV = (LAS unsigned*)(lds + 131072); for (int i = tid; i < 5632; i += 512) CV[i] = (cvt_pk_bf16(cvk[i], 0.f) & 0xffffu) | (cvt_pk_bf16(cvk[5632 + i], 0.f) << 16);
                    if (tid < 2) ((volatile LAS int*)(lds + 155648))[tid] = -1; __syncthreads(); }
                  pg8::EpiSwiglu E{BIG, DFF, pg8::LnFix{Scur, cvk, cvk + 5632}}; pg8::gemm_phase<pg8::EpiSwiglu, pg8::StaticOrder, true, true>(lds, g, S, E); }
                GRID_BAR();
                asel = 0; boff = OFF_W2 + s * SZ_W2; Kres = DFF; sres = 0.5f;
            } else if (si == 1) {
                { PHASE_IDS(); int si_ = si; asm volatile("" : "+s"(si_)); LN_CTX(); ZERO_SNXT(); const int nin = odd ? 2048 : 2560; pg8::Gemm g{XB, Wl + OFF_WIN, T_TOK, nin, 1024}; pg8::StaticOrder S; S.init(T_TOK, nin, G, blk);
                  { LAS unsigned* CV = (LAS unsigned*)(lds + 131072); for (int i = tid; i < nin; i += 512) CV[i] = (cvt_pk_bf16(cvk[i], 0.f) & 0xffffu) | (cvt_pk_bf16(cvk[5632 + i], 0.f) << 16);
                    if (tid < 2) ((volatile LAS int*)(lds + 155648))[tid] = -1; __syncthreads(); }
                  pg8::EpiStore E{BIG, ZW, pg8::LnFix{Scur, cvk, cvk + 5632}}; pg8::gemm_phase<pg8::EpiStore, pg8::StaticOrder, true, true>(lds, g, S, E); }
                GRID_BAR();
                if (!odd) {
                    { PHASE_IDS();
                    for (size_t idx0 = gtid; idx0 < (size_t)T_TOK * 16; idx0 += GT * 4) {
                        u32x4 av[4], bv4[4]; f32x4 tv[4][4];
#pragma unroll
                        for (int q = 0; q < 4; ++q) { const size_t idx = idx0 + (size_t)q * GT; const bool ok = idx < (size_t)T_TOK * 16; const size_t ix = ok ? idx : 0;
                            const int row = (int)(ix >> 4), sub = (int)(ix & 15), qk = sub >> 3, hm = sub & 7, pos = row & (SEQ - 1);
                            const bf16_t* p = Z + (size_t)row * ZW + qk * 512 + hm * 64; av[q] = *(const u32x4*)p; bv4[q] = *(const u32x4*)(p + 8);
#pragma unroll
                            for (int e = 0; e < 4; ++e) tv[q][e] = ((const f32x4*)(ROPE_DA + pos * 8))[e]; }
#pragma unroll
                        for (int q = 0; q < 4; ++q) { const size_t idx = idx0 + (size_t)q * GT; if (idx < (size_t)T_TOK * 16) {
                            const int row = (int)(idx >> 4), sub = (int)(idx & 15), qk = sub >> 3, hm = sub & 7;
                            bf16_t* p = Z + (size_t)row * ZW + qk * 512 + hm * 64; float o1[8], o2[8];
#pragma unroll
                            for (int e = 0; e < 8; ++e) { const unsigned wa = av[q][e >> 1], wb = bv4[q][e >> 1]; const float x1 = (e & 1) ? bfhi(wa) : bflo(wa), x2 = (e & 1) ? bfhi(wb) : bflo(wb);
                                const float cs_ = tv[q][e >> 1][(e & 1) * 2], sn_ = tv[q][e >> 1][(e & 1) * 2 + 1]; o1[e] = x1 * cs_ - x2 * sn_; o2[e] = x1 * sn_ + x2 * cs_; }
                            u32x4 wa, wb; wa.x = cvt_pk_bf16(o1[0], o1[1]); wa.y = cvt_pk_bf16(o1[2], o1[3]); wa.z = cvt_pk_bf16(o1[4], o1[5]); wa.w = cvt_pk_bf16(o1[6], o1[7]);
                            wb.x = cvt_pk_bf16(o2[0], o2[1]); wb.y = cvt_pk_bf16(o2[2], o2[3]); wb.z = cvt_pk_bf16(o2[4], o2[5]); wb.w = cvt_pk_bf16(o2[6], o2[7]);
                            *(u32x4*)p = wa; *(u32x4*)(p + 8) = wb; } }
                    }
                    { const float* cw = P.in[14] + (size_t)hl * 4 * 512; const float* cbs = P.in[15] + (size_t)hl * 512;
                      const int c0 = (int)(gtid & 63) * 8;
                      f32x4 wv[4][2], bb[2];
#pragma unroll
                      for (int j = 0; j < 4; ++j) { wv[j][0] = *(const f32x4*)(cw + j * 512 + c0); wv[j][1] = *(const f32x4*)(cw + j * 512 + c0 + 4); }
                      bb[0] = *(const f32x4*)(cbs + c0); bb[1] = *(const f32x4*)(cbs + c0 + 4);
                      for (size_t idx0 = gtid; idx0 < (size_t)T_TOK * 64; idx0 += GT * 4) {
                        u32x4 xv[4][4];
#pragma unroll
                        for (int q = 0; q < 4; ++q) { const size_t idx = idx0 + (size_t)q * GT; const bool ok = idx < (size_t)T_TOK * 64; const int row = ok ? (int)(idx >> 6) : 3, pos = row & (SEQ - 1);
#pragma unroll
                            for (int j = 0; j < 4; ++j) xv[q][j] = (pos - 3 + j >= 0) ? *(const u32x4*)(Z + (size_t)(row - 3 + j) * ZW + 2048 + c0) : (u32x4){0u, 0u, 0u, 0u}; }
#pragma unroll
                        for (int q = 0; q < 4; ++q) { const size_t idx = idx0 + (size_t)q * GT; if (idx < (size_t)T_TOK * 64) { const int row = (int)(idx >> 6);
                            f32x4 a0 = bb[0], a1 = bb[1];
#pragma unroll
                            for (int j = 0; j < 4; ++j) { const u32x4 v = xv[q][j]; f32x4 x0, x1; x0[0] = bflo(v.x); x0[1] = bfhi(v.x); x0[2] = bflo(v.y); x0[3] = bfhi(v.y); x1[0] = bflo(v.z); x1[1] = bfhi(v.z); x1[2] = bflo(v.w); x1[3] = bfhi(v.w);
                                a0 += wv[j][0] * x0; a1 += wv[j][1] * x1; }
                            u32x4 o; o.x = cvt_pk_bf16(a0[0], a0[1]); o.y = cvt_pk_bf16(a0[2], a0[3]); o.z = cvt_pk_bf16(a1[0], a1[1]); o.w = cvt_pk_bf16(a1[2], a1[3]);
                            *(u32x4*)(XC + (size_t)row * 512 + c0) = o; } }
                      } }
                    }
                    GRID_BAR();
                    { PHASE_IDS(); pg8::Gemm g{XC, Wl + OFF_WEX, T_TOK, 1024, 512}; pg8::StaticOrder S; S.init(T_TOK, 1024, G, blk);
                      pg8::EpiLru E{AB, XC, P.in[17] + (size_t)hl * 1024, (const float*)(ws + WS_SPL) + (size_t)hl * 512};
                      pg8::gemm_phase<pg8::EpiLru, pg8::StaticOrder, true, true>(lds, g, S, E); }
                    GRID_BAR();
                    { PHASE_IDS();
                        const float* lamp = P.in[12] + (size_t)hl * 256; const float* ng = P.in[13] + (size_t)hl * 128;
                        float d1 = lamp[lane] * lamp[64 + lane], d2 = lamp[128 + lane] * lamp[192 + lane]; d1 = wave_sum(d1); d2 = wave_sum(d2);
                        const float lam_init = 0.8f - 0.6f * expf(-0.3f * (float)l);
                        const float lmb = expf(d1) - expf(d2) + lam_init;
                        const int r = lane & 15, g4 = lane >> 4;
                        for (int u = blk; u < 2048; u += G) {
                            const int bh = u & 127, b = bh >> 2, h = bh & 3, qi_ = u >> 7, ii_ = qi_ >> 1, hb_ = qi_ & 1, qt = (ii_ & 1) ? (ii_ - 1 + hb_) : (15 - hb_ - ii_), q0 = qt * 128, nkt = (q0 + 128) / 64;
                            const size_t rb = (size_t)b * SEQ;
                            f32x4 o[2][8]; float ll[2];
                            attn_core3<64, 128, 1, 2, 64>(lds, Z + (rb + q0) * ZW + h * 128, ZW, Z + rb * ZW + 512 + h * 128, ZW, Z + rb * ZW + 1024 + h * 128, ZW, q0, nkt, 0.125f * LOG2E, 0.f, o, ll);
                            const float iv0 = 1.0f / ll[0], f1 = lmb / ll[1]; float ss = 0.f;
#pragma unroll
                            for (int cb = 0; cb < 8; ++cb)
#pragma unroll
                                for (int j = 0; j < 4; ++j) { const float v = o[0][cb][j] * iv0 - f1 * o[1][cb][j]; o[0][cb][j] = v; ss += v * v; }
                            ss = xsum_rows(ss);
                            const float rs = rsqrtf(ss * (1.0f / 128.0f) + LN_EPS) * (1.0f - lam_init);
                            const size_t row = rb + q0 + wave * 16 + r;
                            f32x4 ggv[8];
#pragma unroll
                            for (int cb = 0; cb < 8; ++cb) ggv[cb] = *(const f32x4*)(ng + cb * 16 + g4 * 4);
#pragma unroll
                            for (int cb = 0; cb < 8; ++cb) { const f32x4 gg = ggv[cb]; const f32x4 v = o[0][cb] * rs * gg;
                                u32x2 wv; wv.x = cvt_pk_bf16(v[0], v[1]); wv.y = cvt_pk_bf16(v[2], v[3]); *(u32x2*)(CAT + row * 1024 + h * 128 + cb * 16 + g4 * 4) = wv; }
                        }
                    }
                    { PHASE_IDS();
                        LAS float* sA = (LAS float*)lds; LAS float* sB = sA + 32 * 64;
                        for (int u = blk; u < 256; u += G) {
                            const int b = u >> 3, cgp = u & 7, jc = tid >> 4, q = tid & 15, ch0 = cgp * 64 + q * 4;
                            const size_t row0 = (size_t)b * SEQ + jc * 64;
                            const unsigned* ab = AB + row0 * 512 + ch0;
                            float h[4] = {0.f, 0.f, 0.f, 0.f}, sl[4] = {0.f, 0.f, 0.f, 0.f};
                            for (int t0 = 0; t0 < 64; t0 += 16) {
                                u32x4 wv[16];
#pragma unroll
                                for (int i = 0; i < 16; ++i) wv[i] = *(const u32x4*)(ab + (size_t)(t0 + i) * 512);
#pragma unroll
                                for (int i = 0; i < 16; ++i)
#pragma unroll
                                    for (int k = 0; k < 4; ++k) { const float la = bflo(wv[i][k]), bb = bfhi(wv[i][k]); h[k] = __builtin_amdgcn_exp2f(la) * h[k] + bb; sl[k] += la; }
                            }
                            __syncthreads();
                            *(LAS f32x4*)(sA + jc * 64 + q * 4) = (f32x4){sl[0], sl[1], sl[2], sl[3]}; *(LAS f32x4*)(sB + jc * 64 + q * 4) = (f32x4){h[0], h[1], h[2], h[3]};
                            __syncthreads();
                            float hin[4] = {0.f, 0.f, 0.f, 0.f};
#pragma unroll 8
                            for (int jj = 0; jj < 31; ++jj) { const f32x4 a4 = *(const LAS f32x4*)(sA + jj * 64 + q * 4), b4 = *(const LAS f32x4*)(sB + jj * 64 + q * 4); const bool on = jj < jc;
#pragma unroll
                                for (int k = 0; k < 4; ++k) { const float av = on ? __builtin_amdgcn_exp2f(a4[k]) : 1.0f, bv_ = on ? b4[k] : 0.0f; hin[k] = av * hin[k] + bv_; } }
#pragma unroll
                            for (int k = 0; k < 4; ++k) h[k] = hin[k];
                            const bf16_t* gp = Z + row0 * ZW + 1536 + ch0; bf16_t* op = CAT + row0 * 1024 + 512 + ch0;
                            for (int t0 = 0; t0 < 64; t0 += 16) {
                                u32x4 wv[16]; u32x2 gv2[16];
#pragma unroll
                                for (int i = 0; i < 16; ++i) { wv[i] = *(const u32x4*)(ab + (size_t)(t0 + i) * 512); gv2[i] = *(const u32x2*)(gp + (size_t)(t0 + i) * ZW); }
#pragma unroll
                                for (int i = 0; i < 16; ++i) { float o4[4];
#pragma unroll
                                    for (int k = 0; k < 4; ++k) { const float la = bflo(wv[i][k]), bb = bfhi(wv[i][k]); h[k] = __builtin_amdgcn_exp2f(la) * h[k] + bb;
                                        const unsigned gw = gv2[i][k >> 1]; const float gt = (k & 1) ? bfhi(gw) : bflo(gw); o4[k] = gelu_tanh(gt) * h[k]; }
                                    u32x2 ow; ow.x = cvt_pk_bf16(o4[0], o4[1]); ow.y = cvt_pk_bf16(o4[2], o4[3]); *(u32x2*)(op + (size_t)(t0 + i) * 1024) = ow; }
                            }
                        }
                    }
                    __syncthreads();
                    GRID_BAR();
                } else {
                    { PHASE_IDS();
                    for (size_t idx0 = gtid; idx0 < (size_t)T_TOK * 32; idx0 += GT * 4) {
                        u32x4 av[4], bv4[4]; f32x4 tv[4][4];
#pragma unroll
                        for (int q = 0; q < 4; ++q) { const size_t idx = idx0 + (size_t)q * GT; const bool ok = idx < (size_t)T_TOK * 32; const size_t ix = ok ? idx : 0;
                            const int row = (int)(ix >> 5), sub = (int)(ix & 31), qk = sub >> 4, h = (sub >> 2) & 3, c = sub & 3, pos = row & (SEQ - 1);
                            const bf16_t* p = Z + (size_t)row * ZW + 512 + qk * 256 + h * 64 + c * 8; av[q] = *(const u32x4*)p; bv4[q] = *(const u32x4*)(p + 32);
#pragma unroll
                            for (int e = 0; e < 4; ++e) tv[q][e] = ((const f32x4*)(ROPE_RET + pos * 32 + c * 8))[e]; }
#pragma unroll
                        for (int q = 0; q < 4; ++q) { const size_t idx = idx0 + (size_t)q * GT; if (idx < (size_t)T_TOK * 32) {
                            const int row = (int)(idx >> 5), sub = (int)(idx & 31), qk = sub >> 4, h = (sub >> 2) & 3, c = sub & 3;
                            bf16_t* p = Z + (size_t)row * ZW + 512 + qk * 256 + h * 64 + c * 8; const float ksc = qk ? 0.125f : 1.0f; float o1[8], o2[8];
#pragma unroll
                            for (int e = 0; e < 8; ++e) { const unsigned wa = av[q][e >> 1], wb = bv4[q][e >> 1]; const float x1 = (e & 1) ? bfhi(wa) : bflo(wa), x2 = (e & 1) ? bfhi(wb) : bflo(wb);
                                const float cs_ = tv[q][e >> 1][(e & 1) * 2], sn_ = tv[q][e >> 1][(e & 1) * 2 + 1]; o1[e] = (x1 * cs_ - x2 * sn_) * ksc; o2[e] = (x1 * sn_ + x2 * cs_) * ksc; }
                            u32x4 wa, wb; wa.x = cvt_pk_bf16(o1[0], o1[1]); wa.y = cvt_pk_bf16(o1[2], o1[3]); wa.z = cvt_pk_bf16(o1[4], o1[5]); wa.w = cvt_pk_bf16(o1[6], o1[7]);
                            wb.x = cvt_pk_bf16(o2[0], o2[1]); wb.y = cvt_pk_bf16(o2[2], o2[3]); wb.z = cvt_pk_bf16(o2[4], o2[5]); wb.w = cvt_pk_bf16(o2[6], o2[7]);
                            *(u32x4*)p = wa; *(u32x4*)(p + 32) = wb; } }
                    }
                    }
                    __syncthreads();
                    { PHASE_IDS();
                    if (wave < 4) {
                        for (int u = blk * 4 + wave; u < 1024; u += G * 4)
                            s5_unit(lds + wave * S5_LDS_WAVE, u >> 5, u & 31, P.in[21] + (size_t)hl * 2048, P.in[22] + (size_t)hl * 2048, P.in[23] + (size_t)hl * 32,
                                    P.in[24] + (size_t)hl * 32768, P.in[25] + (size_t)hl * 32768, P.in[26] + (size_t)hl * 32768, P.in[27] + (size_t)hl * 32768,
                                    P.in[28] + (size_t)hl * 512, Z, Z5, lane);
                    }
                    }
                    __syncthreads();
                    GRID_BAR();
                    { PHASE_IDS();
                        const float* rg = P.in[31] + (size_t)hl * 128;
                        const int r = lane & 15, g4 = lane >> 4;
                        for (int u = blk; u < 2048; u += G) {
                            const int bh = u & 127, b = bh >> 2, h = bh & 3, qi_ = u >> 7, ii_ = qi_ >> 1, hb_ = qi_ & 1, qt = (ii_ & 1) ? (ii_ - 1 + hb_) : (15 - hb_ - ii_), q0 = qt * 128, nkt = qt + 1;
                            const size_t rb = (size_t)b * SEQ;
                            const float l2g = log2f(1.0f - exp2f(-5.0f - (float)h));
                            f32x4 o[1][8]; float ll[1];
                            attn_core3<64, 128, 2, 1, 128>(lds, Z + (rb + q0) * ZW + 512 + h * 64, ZW, Z + rb * ZW + 768 + h * 64, ZW, Z + rb * ZW + 1024 + h * 128, ZW, q0, nkt, 1.0f, l2g, o, ll);
                            float sm = 0.f;
#pragma unroll
                            for (int cb = 0; cb < 8; ++cb) sm += (o[0][cb][0] + o[0][cb][1]) + (o[0][cb][2] + o[0][cb][3]);
                            sm = xsum_rows(sm);
                            const float mean = sm * (1.0f / 128.0f); float sq = 0.f;
#pragma unroll
                            for (int cb = 0; cb < 8; ++cb) { o[0][cb] = o[0][cb] - mean; sq += (o[0][cb][0] * o[0][cb][0] + o[0][cb][1] * o[0][cb][1]) + (o[0][cb][2] * o[0][cb][2] + o[0][cb][3] * o[0][cb][3]); }
                            sq = xsum_rows(sq);
                            const float rstd = rsqrtf(sq * (1.0f / 128.0f) + LN_EPS);
                            const size_t row = rb + q0 + wave * 16 + r;
                            f32x4 ggv[8]; u32x2 gwv[8];
#pragma unroll
                            for (int cb = 0; cb < 8; ++cb) { const int col = cb * 16 + g4 * 4; ggv[cb] = *(const f32x4*)(rg + col); gwv[cb] = *(const u32x2*)(Z + row * ZW + 1536 + h * 128 + col); }
#pragma unroll
                            for (int cb = 0; cb < 8; ++cb) { const int col = cb * 16 + g4 * 4; const f32x4 gg = ggv[cb];
                                const u32x2 gw = gwv[cb];
                                f32x4 gt; gt[0] = bflo(gw.x); gt[1] = bfhi(gw.x); gt[2] = bflo(gw.y); gt[3] = bfhi(gw.y);
                                f32x4 v;
#pragma unroll
                                for (int j = 0; j < 4; ++j) v[j] = silu_f(gt[j]) * o[0][cb][j] * rstd * gg[j];
                                u32x2 wv; wv.x = cvt_pk_bf16(v[0], v[1]); wv.y = cvt_pk_bf16(v[2], v[3]); *(u32x2*)(CAT + row * 1024 + 512 + h * 128 + col) = wv; }
                        }
                    }
                    __syncthreads();
                    { PHASE_IDS(); pg8::Gemm g{Z5, Wl + OFF_WEX, T_TOK, 512, 512}; pg8::StaticOrder S; S.init(T_TOK, 512, G, blk);
                      pg8::EpiGlu E{CAT, 1024, Z5, P.in[30] + (size_t)hl * 512};
                      pg8::gemm_phase<pg8::EpiGlu, pg8::StaticOrder, true, true>(lds, g, S, E); }
                    GRID_BAR();
                }
                asel = 1; boff = OFF_WOUT; Kres = 1024; sres = 1.0f;
            } else {
                { PHASE_IDS(); int si_ = si; asm volatile("" : "+s"(si_)); LN_CTX(); ZERO_SNXT(); pg8::Gemm g{XB, Wl + OFF_WQ, T_TOK, 1024, 1024}; pg8::StaticOrder S; S.init(T_TOK, 1024, G, blk);
                  { LAS unsigned* CV = (LAS unsigned*)(lds + 131072); for (int i = tid; i < 1024; i += 512) CV[i] = (cvt_pk_bf16(cvk[i], 0.f) & 0xffffu) | (cvt_pk_bf16(cvk[5632 + i], 0.f) << 16);
                    if (tid < 2) ((volatile LAS int*)(lds + 155648))[tid] = -1; __syncthreads(); }
                  pg8::EpiStore E{BIG, 1024, pg8::LnFix{Scur, cvk, cvk + 5632}}; pg8::gemm_phase<pg8::EpiStore, pg8::StaticOrder, true, true>(lds, g, S, E); }
                { PHASE_IDS(); pg8::Gemm g{MEMB, Wl + OFF_WKV, MEMT, 2048, 1024}; pg8::StaticOrder S; S.init(MEMT, 2048, G, blk);
                  pg8::EpiStore E{KV, 2048, pg8::LnFix{nullptr, nullptr, nullptr}}; pg8::gemm_phase<pg8::EpiStore, pg8::StaticOrder, true, true>(lds, g, S, E); }
                GRID_BAR();
                { PHASE_IDS();
                    const int r = lane & 15, g4 = lane >> 4;
                    for (int u = blk; u < 2048; u += G) {
                        const int bh = u & 127, b = bh >> 2, h = bh & 3, qt = u >> 7, q0 = qt * 128;
                        const size_t rb = (size_t)b * SEQ;
                        f32x4 o[1][16]; float ll[1];
                        attn_core3<256, 256, 0, 1, 64>(lds, BIG + (rb + q0) * 1024 + h * 256, 1024, KV + (size_t)b * 256 * 2048 + h * 256, 2048, KV + (size_t)b * 256 * 2048 + 1024 + h * 256, 2048, q0, 4, 0.0625f * LOG2E, 0.f, o, ll);
                        const float iv = 1.0f / ll[0]; const size_t row = rb + q0 + wave * 16 + r;
#pragma unroll
                        for (int cb = 0; cb < 16; ++cb) { const f32x4 v = o[0][cb] * iv; u32x2 wv; wv.x = cvt_pk_bf16(v[0], v[1]); wv.y = cvt_pk_bf16(v[2], v[3]);
                            *(u32x2*)(CAT + row * 1024 + h * 256 + cb * 16 + g4 * 4) = wv; }
                    }
                }
                __syncthreads();
                GRID_BAR();
                asel = 1; boff = OFF_WO; Kres = 1024; sres = 1.0f;
            }
            { PHASE_IDS(); int si_ = si; asm volatile("" : "+s"(si_)); LN_CTX(); pg8::Gemm g{asel ? CAT : BIG, Wl + boff, T_TOK, 1024, Kres}; pg8::StaticOrder S; S.init(T_TOK, 1024, G, blk);
              const float* gpv = kcur ? P.in[2] + (size_t)(kcur - 1) * 1024 : (const float*)(ws + WS_ONES); const float* bpv = kcur ? P.in[3] + (size_t)(kcur - 1) * 1024 : (const float*)(ws + WS_ZEROS);
              { LAS float* gl = (LAS float*)(lds + 147456); for (int i = tid; i < 1024; i += 512) { gl[i] = gpv[i]; gl[1024 + i] = bpv[i]; } __syncthreads(); }
              pg8::EpiResid E{X, XB, Scur, Snxt, gpv, bpv, DN_ALPHA, sres}; pg8::gemm_phase<pg8::EpiResid, pg8::StaticOrder, true, true>(lds, g, S, E); }
            GRID_BAR();
            if (lcur == 3 && si == 3) { PHASE_IDS();
                const float* gp = P.in[2] + (size_t)15 * 1024; const float* bp = P.in[3] + (size_t)15 * 1024;
                f32x4 gv[4], bv[4];
#pragma unroll
                for (int j = 0; j < 4; ++j) { gv[j] = ((const f32x4*)gp)[lane + 64 * j]; bv[j] = ((const f32x4*)bp)[lane + 64 * j]; }
                for (int mrow0 = gw; mrow0 < T_TOK; mrow0 += 2 * NGW) {
                    f32x4 v[2][4];
#pragma unroll
                    for (int q = 0; q < 2; ++q) { const int mrow = (mrow0 + q * NGW < T_TOK) ? mrow0 + q * NGW : mrow0;
#pragma unroll
                        for (int j = 0; j < 4; ++j) { const unsigned long long hw = ((const unsigned long long*)(XB + (size_t)mrow * 1024))[lane + 64 * j], lw = ((const unsigned long long*)(X + (size_t)mrow * 1024))[256 + lane + 64 * j];
                            const unsigned h0 = (unsigned)hw, h1 = (unsigned)(hw >> 32), l0 = (unsigned)lw, l1 = (unsigned)(lw >> 32);
                            v[q][j][0] = bflo(h0) + bflo(l0); v[q][j][1] = bfhi(h0) + bfhi(l0); v[q][j][2] = bflo(h1) + bflo(l1); v[q][j][3] = bfhi(h1) + bfhi(l1); } }
#pragma unroll
                    for (int q = 0; q < 2; ++q) { const int mrow = mrow0 + q * NGW; if (mrow < T_TOK) {
                        f32x4* xr = (f32x4*)(X + (size_t)mrow * 1024) + lane; float s = 0.f;
#pragma unroll
                        for (int j = 0; j < 4; ++j) s += (v[q][j][0] + v[q][j][1]) + (v[q][j][2] + v[q][j][3]);
                        const float mean = wave_sum(s) * (1.0f / 1024.0f); float s2 = 0.f;
#pragma unroll
                        for (int j = 0; j < 4; ++j) { v[q][j] = v[q][j] - mean; s2 += (v[q][j][0] * v[q][j][0] + v[q][j][1] * v[q][j][1]) + (v[q][j][2] * v[q][j][2] + v[q][j][3] * v[q][j][3]); }
                        const float rstd = rsqrtf(wave_sum(s2) * (1.0f / 1024.0f) + LN_EPS);
#pragma unroll
                        for (int j = 0; j < 4; ++j) { const f32x4 y = v[q][j] * rstd * gv[j] + bv[j]; xr[64 * j] = y; } } }
                }
            }
        }
    }
}

extern "C" void kernel_launch(void* const* d_in, const int* in_sizes, int n_in, void* d_out, int out_size, void* d_ws, size_t ws_size, hipStream_t stream) {
    static int grid_blocks = 0;
    if (grid_blocks == 0) {
        if (n_in != 32 || out_size != T_TOK * DM || ws_size < WS_END) { fprintf(stderr, "kernel_launch: unexpected shapes (n_in %d out %d ws %zu)\n", n_in, out_size, ws_size); grid_blocks = -1; return; }
        int dev = 0, cus = 0, per_cu = 0;
        hipGetDevice(&dev); hipDeviceGetAttribute(&cus, hipDeviceAttributeMultiprocessorCount, dev);
        if (hipFuncSetAttribute((const void*)mega_fwd, hipFuncAttributeMaxDynamicSharedMemorySize, LDS_BYTES) != hipSuccess) { fprintf(stderr, "kernel_launch: hipFuncSetAttribute failed\n"); }
        if (hipOccupancyMaxActiveBlocksPerMultiprocessor(&per_cu, (const void*)mega_fwd, 512, LDS_BYTES) != hipSuccess || per_cu < 1) { fprintf(stderr, "kernel_launch: occupancy query says %d\n", per_cu); per_cu = 1; }
        (void)hipGetLastError();
        grid_blocks = cus * 1;
        fprintf(stderr, "kernel_launch: cus %d per_cu %d grid %d\n", cus, per_cu, grid_blocks);
    }
    if (grid_blocks < 0) return;
    Params p{};
    for (int i = 0; i < 32; ++i) p.in[i] = (const float*)d_in[i];
    p.out = (float*)d_out; p.ws = (unsigned char*)d_ws;
    if (hipMemsetAsync(d_ws, 0, 16384, stream) != hipSuccess) { fprintf(stderr, "kernel_launch: memset failed\n"); return; }
    void* args[] = {&p};
    hipError_t e = hipLaunchCooperativeKernel((const void*)mega_fwd, dim3(grid_blocks), dim3(512), args, LDS_BYTES, stream);
    if (e != hipSuccess) fprintf(stderr, "cooperative launch failed: %s (grid %d)\n", hipGetErrorString(e), grid_blocks);
}
```
